# Optimizing an MI355X kernel written in HIP

```python
import math
import jax, jax.numpy as jnp
from jax import lax

D_MODEL = 1024
BATCH = 8
SEQ = 4096
DEPTH = 2
DEC_BATCH = 128
DEC_SEQ = 1
PAST_LEN = 16384
PAGE_SIZE = 128

MIX_DIM = D_MODEL
DN_DK = 128
DN_DV = 128
DN_HEADS = (MIX_DIM // 2) // DN_DV
SWA_DH = 64
SWA_HEADS = (MIX_DIM - DN_HEADS * DN_DV) // SWA_DH
SWA_KV_HEADS = SWA_HEADS // 4
SWA_GROUP = SWA_HEADS // SWA_KV_HEADS
WINDOW = 128
DN_CONV = 4
DN_CHUNK = 64
ROPE_THETA = 10000.0
D_FF = ((8 * D_MODEL // 3 + 127) // 128) * 128
N_MOD = 9
EPS = 1e-6
DN_QK = DN_HEADS * DN_DK
DN_V = DN_HEADS * DN_DV
DN_CONV_CH = 2 * DN_QK + DN_V
SWA_Q = SWA_HEADS * SWA_DH
SWA_KV = SWA_KV_HEADS * SWA_DH
SPLIT_POINTS = (DN_CONV_CH, DN_CONV_CH + DN_V, DN_CONV_CH + DN_V + DN_HEADS,
                DN_CONV_CH + DN_V + 2 * DN_HEADS, DN_CONV_CH + DN_V + 2 * DN_HEADS + SWA_Q,
                DN_CONV_CH + DN_V + 2 * DN_HEADS + SWA_Q + SWA_KV)
IN_DIM = SPLIT_POINTS[-1] + SWA_KV

kernel_name = 'hymba_gdn_swa_macaron_adaln_step'


def _rms_norm(x, w):
    xf = x.astype(jnp.float32)
    y = xf * lax.rsqrt(jnp.mean(xf * xf, axis=-1, keepdims=True) + EPS)
    return (y * w.astype(jnp.float32)).astype(x.dtype)


def _l2norm(x):
    return x * lax.rsqrt(jnp.sum(x * x, axis=-1, keepdims=True) + EPS)


def _adaln(c, w_ada, b_ada):
    m = jax.nn.silu(c) @ w_ada + b_ada
    return m.reshape(c.shape[0], N_MOD, 1, D_MODEL)


def _modulate(x, g, shift, scale):
    return _rms_norm(x, g) * (1.0 + scale) + shift


def _swiglu(h, w_gu, w_down):
    a, b = jnp.split(h @ w_gu, 2, axis=-1)
    return (jax.nn.silu(a) * b) @ w_down


def _rope(x, pos):
    d = x.shape[-1]
    half = d // 2
    inv = jnp.power(ROPE_THETA, -jnp.arange(half, dtype=jnp.float32) * 2.0 / d)
    ang = pos.astype(jnp.float32)[:, None] * inv[None, :]
    cos = jnp.cos(ang)[:, None, :]
    sin = jnp.sin(ang)[:, None, :]
    xf = x.astype(jnp.float32)
    x1, x2 = xf[..., :half], xf[..., half:]
    return jnp.concatenate([x1 * cos - x2 * sin, x2 * cos + x1 * sin], axis=-1).astype(x.dtype)


def _causal_conv(x, buf, w):
    T = x.shape[1]
    xp = jnp.concatenate([buf.astype(x.dtype), x], axis=1)
    y = xp[:, 0:T] * w[0]
    for j in range(1, DN_CONV):
        y = y + xp[:, j:j + T] * w[j]
    return y, xp[:, T:]


def _gated_delta_chunked(q, k, v, g, beta, S0):
    B, T, H, dk = q.shape
    dv = v.shape[-1]
    C = min(DN_CHUNK, T)
    pad = (-T) % C
    Tp = T + pad
    N = Tp // C

    def chunks(a):
        a = jnp.pad(a, [(0, 0), (0, pad)] + [(0, 0)] * (a.ndim - 2))
        a = a.reshape((B, N, C) + a.shape[2:])
        return jnp.moveaxis(a, 2, 3)

    q, k, v, g, beta = chunks(q), chunks(k), chunks(v), chunks(g), chunks(beta)
    gc = jnp.cumsum(g, axis=-1)
    idx = jnp.arange(C)
    incl = idx[:, None] >= idx[None, :]
    strict = idx[:, None] > idx[None, :]
    decay = jnp.exp(jnp.where(incl, gc[..., :, None] - gc[..., None, :], -jnp.inf))
    kb = k * beta[..., None]
    A = jnp.where(strict, jnp.einsum('bnhid,bnhjd->bnhij', kb, k) * decay, 0.0)
    eye = jnp.eye(C, dtype=jnp.float32)
    Tinv = lax.linalg.triangular_solve(eye + A, jnp.broadcast_to(eye, A.shape),
                                       left_side=True, lower=True, unit_diagonal=True)
    u = jnp.einsum('bnhij,bnhjd->bnhid', Tinv, v * beta[..., None])
    w = jnp.einsum('bnhij,bnhjd->bnhid', Tinv, kb * jnp.exp(gc)[..., None])
    qk = jnp.where(incl, jnp.einsum('bnhid,bnhjd->bnhij', q, k) * decay, 0.0)
    qd = q * jnp.exp(gc)[..., None]
    g_last = gc[..., -1]
    kd = k * jnp.exp(g_last[..., None] - gc)[..., None]

    def step(S, xs):
        u_n, w_n, qk_n, qd_n, kd_n, gl_n = xs
        v_new = u_n - jnp.einsum('bhcd,bhde->bhce', w_n, S)
        o_n = jnp.einsum('bhcd,bhde->bhce', qd_n, S) + jnp.einsum('bhij,bhje->bhie', qk_n, v_new)
        S = S * jnp.exp(gl_n)[..., None, None] + jnp.einsum('bhcd,bhce->bhde', kd_n, v_new)
        return S, o_n

    xs = tuple(jnp.moveaxis(a, 1, 0) for a in (u, w, qk, qd, kd, g_last))
    S, o = lax.scan(step, S0, xs)
    o = jnp.transpose(o, (1, 0, 3, 2, 4)).reshape(B, Tp, H, dv)[:, :T]
    return o, S


def _deltanet(p_conv, p_z, p_b, p_a, conv_buf, S0, conv_w, A_log, dt_bias, norm_w):
    B, T, _ = p_conv.shape
    qkv, conv_new = _causal_conv(p_conv, conv_buf, conv_w)
    qkv = jax.nn.silu(qkv.astype(jnp.float32))
    q, k, v = jnp.split(qkv, [DN_QK, 2 * DN_QK], axis=-1)
    q = _l2norm(q.reshape(B, T, DN_HEADS, DN_DK)) * (DN_DK ** -0.5)
    k = _l2norm(k.reshape(B, T, DN_HEADS, DN_DK))
    v = v.reshape(B, T, DN_HEADS, DN_DV)
    beta = jax.nn.sigmoid(p_b.astype(jnp.float32))
    g = -jnp.exp(A_log.astype(jnp.float32)) * jax.nn.softplus(
        p_a.astype(jnp.float32) + dt_bias.astype(jnp.float32))
    o, S = _gated_delta_chunked(q, k, v, g, beta, S0.astype(jnp.float32))
    z = p_z.reshape(B, T, DN_HEADS, DN_DV).astype(jnp.float32)
    o = _rms_norm(o, norm_w) * jax.nn.silu(z)
    return o.reshape(B, T, DN_V).astype(p_conv.dtype), S, conv_new


def _sink_softmax(s, mask, sink):
    s = jnp.where(mask, s, -jnp.inf)
    m = jnp.maximum(jnp.max(s, axis=-1, keepdims=True), sink)
    p = jnp.exp(s - m)
    return p / (jnp.sum(p, axis=-1, keepdims=True) + jnp.exp(sink - m))


def _swa_banded(q, k, v, sinks):
    B, T = q.shape[0], q.shape[1]
    nb = T // WINDOW
    qb = q.reshape(B, nb, WINDOW, SWA_KV_HEADS, SWA_GROUP, SWA_DH).astype(jnp.float32)
    kb = k.reshape(B, nb, WINDOW, SWA_KV_HEADS, SWA_DH).astype(jnp.float32)
    vb = v.reshape(B, nb, WINDOW, SWA_KV_HEADS, SWA_DH).astype(jnp.float32)
    shift = ((0, 0), (1, 0), (0, 0), (0, 0), (0, 0))
    kk = jnp.concatenate([jnp.pad(kb, shift)[:, :-1], kb], axis=2)
    vv = jnp.concatenate([jnp.pad(vb, shift)[:, :-1], vb], axis=2)
    s = jnp.einsum('bnqhgd,bnkhd->bnhgqk', qb, kk) * (SWA_DH ** -0.5)
    qi = jnp.arange(WINDOW)[:, None] + WINDOW
    kj = jnp.arange(2 * WINDOW)[None, :]
    dist = qi - kj
    kglob = jnp.arange(nb)[:, None, None] * WINDOW - WINDOW + kj[None]
    mask = (dist >= 0) & (dist <= WINDOW) & (kglob >= 0)
    sink = sinks.astype(jnp.float32).reshape(1, 1, SWA_KV_HEADS, SWA_GROUP, 1, 1)
    p = _sink_softmax(s, mask[None, :, None, None], sink)
    o = jnp.einsum('bnhgqk,bnkhd->bnqhgd', p, vv)
    return o.reshape(B, T, SWA_Q).astype(q.dtype)


def _swa_step(q, k, v, k_buf, v_buf, sinks):
    B, T = q.shape[0], q.shape[1]
    W0 = k_buf.shape[1]
    kk = jnp.concatenate([k_buf.astype(k.dtype), k], axis=1)
    vv = jnp.concatenate([v_buf.astype(v.dtype), v], axis=1)
    qpos = PAST_LEN + jnp.arange(T)
    kpos = PAST_LEN - W0 + jnp.arange(W0 + T)
    dist = qpos[:, None] - kpos[None, :]
    mask = (dist >= 0) & (dist <= WINDOW)
    qg = q.reshape(B, T, SWA_KV_HEADS, SWA_GROUP, SWA_DH).astype(jnp.float32)
    s = jnp.einsum('bqhgd,bkhd->bhgqk', qg, kk.astype(jnp.float32)) * (SWA_DH ** -0.5)
    sink = sinks.astype(jnp.float32).reshape(1, SWA_KV_HEADS, SWA_GROUP, 1, 1)
    p = _sink_softmax(s, mask, sink)
    o = jnp.einsum('bhgqk,bkhd->bqhgd', p, vv.astype(jnp.float32))
    return o.reshape(B, T, SWA_Q).astype(q.dtype), kk[:, T:], vv[:, T:]


def _layer(x, c, pos, conv_buf, S0, k_buf, v_buf, prm):
    (w_ada, b_ada, g_ffn1, w_ffn1_gu, w_ffn1_down, g_mix, w_in, dn_conv_w, dn_A_log, dn_dt_bias,
     dn_norm_w, swa_q_norm, swa_k_norm, swa_sinks, w_out, g_ffn2, w_ffn2_gu, w_ffn2_down) = prm
    B, T, _ = x.shape
    m = _adaln(c, w_ada, b_ada)
    h = _modulate(x, g_ffn1, m[:, 0], m[:, 1])
    x = x + 0.5 * m[:, 2] * _swiglu(h, w_ffn1_gu, w_ffn1_down)
    h = _modulate(x, g_mix, m[:, 3], m[:, 4])
    p_conv, p_z, p_b, p_a, p_q, p_k, p_v = jnp.split(h @ w_in, SPLIT_POINTS, axis=-1)
    dn_out, S_new, conv_new = _deltanet(p_conv, p_z, p_b, p_a, conv_buf, S0, dn_conv_w,
                                        dn_A_log, dn_dt_bias, dn_norm_w)
    q = _rope(_rms_norm(p_q.reshape(B, T, SWA_HEADS, SWA_DH), swa_q_norm), pos)
    k = _rope(_rms_norm(p_k.reshape(B, T, SWA_KV_HEADS, SWA_DH), swa_k_norm), pos)
    v = p_v.reshape(B, T, SWA_KV_HEADS, SWA_DH)
    if k_buf is None:
        swa_out = _swa_banded(q, k, v, swa_sinks)
        nkeep = min(WINDOW, T)
        k_new, v_new = k[:, T - nkeep:], v[:, T - nkeep:]
    else:
        swa_out, k_new, v_new = _swa_step(q, k, v, k_buf, v_buf, swa_sinks)
    mix = jnp.concatenate([dn_out, swa_out], axis=-1) @ w_out
    x = x + m[:, 5] * mix
    h = _modulate(x, g_ffn2, m[:, 6], m[:, 7])
    x = x + 0.5 * m[:, 8] * _swiglu(h, w_ffn2_gu, w_ffn2_down)
    return x, conv_new, S_new, k_new, v_new


def setup_inputs(seed: int = 0) -> dict:
    key = jax.random.key(seed)
    ks = jax.random.split(key, 32)
    f32 = jnp.float32
    L, D = DEPTH, D_MODEL
    swa_buf = min(WINDOW, PAST_LEN)

    def nrm(k, shape, s):
        return jax.random.normal(k, shape, f32) * s

    def gain(k, shape):
        return 1.0 + 0.02 * jax.random.normal(k, shape, f32)

    A = jax.random.uniform(ks[20], (L, DN_HEADS), f32, 1.0, 16.0)
    dt = jnp.exp(jax.random.uniform(ks[21], (L, DN_HEADS), f32, math.log(1e-3), math.log(1e-1)))
    return {
        'x_prompt': nrm(ks[0], (BATCH, SEQ, D), 1.0),
        'x_sample': nrm(ks[1], (DEC_BATCH, DEC_SEQ, D), 1.0),
        'c_prompt': nrm(ks[2], (BATCH, D), 1.0),
        'c_sample': nrm(ks[3], (DEC_BATCH, D), 1.0),
        'state_dn_conv': nrm(ks[4], (L, DEC_BATCH, DN_CONV - 1, DN_CONV_CH), 1.0),
        'state_dn_S': nrm(ks[5], (L, DEC_BATCH, DN_HEADS, DN_DK, DN_DV), DN_DK ** -0.5),
        'cache_swa_k': nrm(ks[6], (L, DEC_BATCH, swa_buf, SWA_KV_HEADS, SWA_DH), 1.0),
        'cache_swa_v': nrm(ks[7], (L, DEC_BATCH, swa_buf, SWA_KV_HEADS, SWA_DH), 1.0),
        'w_ada': nrm(ks[8], (L, D, N_MOD * D), 0.5 * D ** -0.5),
        'b_ada': nrm(ks[9], (L, N_MOD * D), 0.01),
        'g_ffn1': gain(ks[10], (L, D)),
        'w_ffn1_gu': nrm(ks[11], (L, D, 2 * D_FF), D ** -0.5),
        'w_ffn1_down': nrm(ks[12], (L, D_FF, D), D_FF ** -0.5),
        'g_mix': gain(ks[13], (L, D)),
        'w_in': nrm(ks[14], (L, D, IN_DIM), D ** -0.5),
        'dn_conv_w': nrm(ks[15], (L, DN_CONV, DN_CONV_CH), DN_CONV ** -0.5),
        'dn_A_log': jnp.log(A),
        'dn_dt_bias': dt + jnp.log(-jnp.expm1(-dt)),
        'dn_norm_w': gain(ks[16], (L, DN_DV)),
        'swa_q_norm': gain(ks[17], (L, SWA_DH)),
        'swa_k_norm': gain(ks[18], (L, SWA_DH)),
        'swa_sinks': nrm(ks[19], (L, SWA_HEADS), 0.5),
        'w_out': nrm(ks[22], (L, MIX_DIM, D), MIX_DIM ** -0.5),
        'g_ffn2': gain(ks[23], (L, D)),
        'w_ffn2_gu': nrm(ks[24], (L, D, 2 * D_FF), D ** -0.5),
        'w_ffn2_down': nrm(ks[25], (L, D_FF, D), D_FF ** -0.5),
    }


def reference(x_prompt, x_sample, c_prompt, c_sample, state_dn_conv, state_dn_S, cache_swa_k,
              cache_swa_v, w_ada, b_ada, g_ffn1, w_ffn1_gu, w_ffn1_down, g_mix, w_in, dn_conv_w,
              dn_A_log, dn_dt_bias, dn_norm_w, swa_q_norm, swa_k_norm, swa_sinks, w_out, g_ffn2,
              w_ffn2_gu, w_ffn2_down):
    Bp, Tp = x_prompt.shape[0], x_prompt.shape[1]
    pos_p = jnp.arange(Tp)
    pos_s = PAST_LEN + jnp.arange(x_sample.shape[1])
    yp, ys = x_prompt, x_sample
    p_conv, p_S, p_k, p_v = [], [], [], []
    s_conv, s_S, s_k, s_v = [], [], [], []
    for l in range(DEPTH):
        prm = (w_ada[l], b_ada[l], g_ffn1[l], w_ffn1_gu[l], w_ffn1_down[l], g_mix[l], w_in[l],
               dn_conv_w[l], dn_A_log[l], dn_dt_bias[l], dn_norm_w[l], swa_q_norm[l],
               swa_k_norm[l], swa_sinks[l], w_out[l], g_ffn2[l], w_ffn2_gu[l], w_ffn2_down[l])
        conv0 = jnp.zeros((Bp, DN_CONV - 1, DN_CONV_CH), x_prompt.dtype)
        S0 = jnp.zeros((Bp, DN_HEADS, DN_DK, DN_DV), jnp.float32)
        yp, cv, S, kn, vn = _layer(yp, c_prompt, pos_p, conv0, S0, None, None, prm)
        p_conv.append(cv); p_S.append(S); p_k.append(kn); p_v.append(vn)
        ys, cv, S, kn, vn = _layer(ys, c_sample, pos_s, state_dn_conv[l], state_dn_S[l],
                                   cache_swa_k[l], cache_swa_v[l], prm)
        s_conv.append(cv); s_S.append(S); s_k.append(kn); s_v.append(vn)
    return (yp, ys, jnp.stack(p_conv), jnp.stack(p_S), jnp.stack(p_k), jnp.stack(p_v),
            jnp.stack(s_conv), jnp.stack(s_S), jnp.stack(s_k), jnp.stack(s_v))
```

```cpp
#include <hip/hip_runtime.h>
#include <hip/hip_cooperative_groups.h>
#include <cstdio>
namespace cg = cooperative_groups;
#include <hip/hip_runtime.h>
namespace pg8 {
#define PG8_LAS __attribute__((address_space(3)))
typedef unsigned short bf16_t;
typedef short bf16x8 __attribute__((ext_vector_type(8)));
typedef float f32x4 __attribute__((ext_vector_type(4)));
typedef unsigned u32x4 __attribute__((ext_vector_type(4)));
constexpr int BM = 256, BK = 64, HALF = 128, HTB = HALF * BK * 2  , STAGE_BYTES = 8 * HTB, NXCD = 8, WGM = 8;

__host__ __device__ __forceinline__ int lds_byte(int r, int c) { const int st = (r >> 4) * 2 + (c >> 5), rr = r & 15, cc = c & 31, ob = rr * 64 + cc * 2; return st * 1024 + (ob ^ (((ob >> 9) & 1) << 5)); }
__host__ __device__ __forceinline__ void stage_rc(int b, int& R, int& C) { const int st = b / 1024, sb = b % 1024, swz = sb ^ (((sb >> 9) & 1) << 5); R = (st >> 1) * 16 + swz / 64; C = (st & 1) * 32 + (swz % 64) / 2; }
__host__ __device__ __forceinline__ int perm32(int rho) { const int n = rho >> 4, i = rho & 15; return 8 * (i >> 2) + 4 * n + (i & 3); }

struct Unit { int pm, pn; };
struct Gemm { const bf16_t* A; const bf16_t* Bt; int M, N, K; };

struct StaticOrder {
    int nM, nN, nwg, G, c;
    __host__ __device__ void init(int M, int N, int G_, int c_) { nM = M / BM; nN = N / BM; nwg = nM * nN; G = G_; c = c_; }
    __host__ __device__ bool next(int i, Unit& u) const {
        const long L = (long)i * G + c; if (L >= nwg) return false;
        int wgid = (int)L; { const int q = nwg / NXCD, r = nwg % NXCD, xcd = wgid % NXCD, off = wgid / NXCD; wgid = (xcd < r ? xcd * (q + 1) : r * (q + 1) + (xcd - r) * q) + off; }
        const int nig = WGM * nN, gid = wgid / nig, fm = gid * WGM, gsz = (nM - fm) < WGM ? (nM - fm) : WGM;
        u.pm = fm + ((wgid % nig) % gsz); u.pn = (wgid % nig) / gsz; return true;
    }
    __device__ __forceinline__ void a_ready(const Unit&) const {}
    __device__ __forceinline__ void done(const Unit&) const {}
};
__device__ __forceinline__ unsigned cvt_pk_bf16(float lo, float hi) { unsigned r; asm volatile("v_cvt_pk_bf16_f32 %0, %1, %2" : "=v"(r) : "v"(lo), "v"(hi)); return r; }
template <class Epi, class Sched, bool STAMP = false>
__device__ __forceinline__ void gemm_phase(PG8_LAS unsigned char* lds, const Gemm g, const Sched& S, const Epi& E, unsigned long long* stamps) {
    int tid_ = threadIdx.x; asm volatile("" : "+v"(tid_)); const int tid = tid_, wid = __builtin_amdgcn_readfirstlane(tid >> 6), lane = tid & 63, wr = wid >> 2, wc = wid & 3, fr = lane & 15, fq = lane >> 4;
    const int K = g.K, nt = K / BK;
    int ts_lo = 0, ts_hi = 0, nts = 0; const unsigned long long rt_entry = STAMP ? (unsigned long long)wall_clock64() : 0ull;
#define PG8_STAMP() do { if (STAMP && wid == 0 && nts < 64) { const unsigned long long _c = (unsigned long long)clock64(); \
        ts_lo = (lane == nts) ? (int)(unsigned)_c : ts_lo; ts_hi = (lane == nts) ? (int)(unsigned)(_c >> 32) : ts_hi; ++nts; } } while (0)
    PG8_STAMP();
    unsigned voffA[2], voffB[2];
#pragma unroll
    for (int i = 0; i < 2; ++i) { int R, C; stage_rc(tid * 16 + i * 8192, R, C); const int Rb = Epi::PERM ? ((R & ~31) + perm32(R & 31)) : R;
        voffA[i] = (unsigned)(R * K + C) * 2u; voffB[i] = (unsigned)(Rb * K + C) * 2u; }
    const size_t kstep = (size_t)(BK * 2);
    const size_t hstep = (size_t)HALF * K * 2;
    const size_t tstep = 2 * hstep;
    const unsigned ldsw = (unsigned)wid * 1024u;
    const int aoff = lds_byte(wr * 64 + fr, fq * 8), boff = lds_byte(wc * 32 + fr, fq * 8);
#define PG8_SA(b, h) (((b) * 2 + (h)) * HTB)
#define PG8_SB(b, h) ((4 + (b) * 2 + (h)) * HTB)
#define PG8_STAGE(bufoff, gbase, voff) do { _Pragma("unroll") for (int _i = 0; _i < 2; ++_i) \
        __builtin_amdgcn_global_load_lds((const unsigned*)((const char*)(gbase) + (voff)[_i]), (PG8_LAS unsigned*)(lds + (bufoff) + ldsw + _i * 8192), 16, 0, 0); } while (0)
#define PG8_LDA(dst, b, h) do { _Pragma("unroll") for (int m = 0; m < 4; ++m) _Pragma("unroll") for (int k = 0; k < 2; ++k) dst[m][k] = *(const PG8_LAS bf16x8*)(lds + PG8_SA(b, h) + aoff + m * 2048 + k * 1024); } while (0)
#define PG8_LDB(dst, b, h) do { _Pragma("unroll") for (int n = 0; n < 2; ++n) _Pragma("unroll") for (int k = 0; k < 2; ++k) dst[n][k] = *(const PG8_LAS bf16x8*)(lds + PG8_SB(b, h) + boff + n * 2048 + k * 1024); } while (0)
#define PG8_MMA(ai, bj, At, Bt) do { __builtin_amdgcn_s_setprio(1); _Pragma("unroll") for (int m = 0; m < 4; ++m) _Pragma("unroll") for (int n = 0; n < 2; ++n) _Pragma("unroll") for (int k = 0; k < 2; ++k) \
        acc[ai][bj][m][n] = __builtin_amdgcn_mfma_f32_16x16x32_bf16(Bt[n][k], At[m][k], acc[ai][bj][m][n], 0, 0, 0); __builtin_amdgcn_s_setprio(0); } while (0)
#define PG8_WAIT_V(n) asm volatile("s_waitcnt vmcnt(" #n ")" ::: "memory")
#define PG8_WAIT_L(n) asm volatile("s_waitcnt lgkmcnt(" #n ")" ::: "memory")
#define PG8_BAR __builtin_amdgcn_s_barrier()
#define PG8_SCHED __builtin_amdgcn_sched_barrier(0)
    Unit cur, nxt; int ui = 0;
    if (!S.next(0, cur)) return;
    f32x4 acc[2][2][4][2];
#pragma unroll
    for (int a = 0; a < 2; ++a)
#pragma unroll
        for (int b = 0; b < 2; ++b)
#pragma unroll
            for (int m = 0; m < 4; ++m)
#pragma unroll
                for (int n = 0; n < 2; ++n) acc[a][b][m][n] = (f32x4){0.f, 0.f, 0.f, 0.f};
    bf16x8 At[4][2], B0[2][2], B1[2][2];
    const char* cA = (const char*)g.A + (size_t)cur.pm * tstep; const char* cB = (const char*)g.Bt + (size_t)cur.pn * tstep;
    S.a_ready(cur);
    PG8_STAGE(PG8_SB(0, 0), cB, voffB); PG8_STAGE(PG8_SA(0, 0), cA, voffA); PG8_STAGE(PG8_SB(0, 1), cB + hstep, voffB); PG8_STAGE(PG8_SA(0, 1), cA + hstep, voffA);
    if (wr == 1) PG8_BAR;
    PG8_WAIT_V(4); PG8_BAR;
    PG8_STAGE(PG8_SB(1, 0), cB + kstep, voffB); PG8_STAGE(PG8_SA(1, 0), cA + kstep, voffA); PG8_STAGE(PG8_SB(1, 1), cB + hstep + kstep, voffB);
    PG8_WAIT_V(6); PG8_BAR;
    PG8_STAMP();
    for (;;) {
        const bool has_next = S.next(ui + 1, nxt);
        const char* nA = has_next ? (const char*)g.A + (size_t)nxt.pm * tstep : cA; const char* nB = has_next ? (const char*)g.Bt + (size_t)nxt.pn * tstep : cB;
        for (int t = 0; t < nt; t += 2) {
            const bool last = (t == nt - 2);
            const char* a1 = cA + (size_t)(t + 1) * kstep;
            const char* a2 = last ? nA : cA + (size_t)(t + 2) * kstep; const char* b2 = last ? nB : cB + (size_t)(t + 2) * kstep;
            const char* a3 = a2 + kstep; const char* b3 = b2 + kstep;
            if (last && has_next) S.a_ready(nxt);
            PG8_LDB(B0, 0, 0); PG8_SCHED; PG8_LDA(At, 0, 0); PG8_STAGE(PG8_SA(1, 1), a1 + hstep, voffA);
            PG8_WAIT_L(8); PG8_BAR; PG8_WAIT_L(0); PG8_MMA(0, 0, At, B0); PG8_BAR; PG8_SCHED;
            PG8_LDB(B1, 0, 1); PG8_STAGE(PG8_SB(0, 0), b2, voffB);
            PG8_BAR; PG8_WAIT_L(0); PG8_MMA(0, 1, At, B1); PG8_BAR;
            PG8_LDA(At, 0, 1); PG8_STAGE(PG8_SA(0, 0), a2, voffA);
            PG8_BAR; PG8_WAIT_L(0); PG8_MMA(1, 0, At, B0); PG8_BAR; PG8_SCHED;
            PG8_STAGE(PG8_SB(0, 1), b2 + hstep, voffB);
            PG8_WAIT_V(6); PG8_BAR; PG8_MMA(1, 1, At, B1); PG8_BAR;
            PG8_LDB(B0, 1, 0); PG8_SCHED; PG8_LDA(At, 1, 0); PG8_STAGE(PG8_SA(0, 1), a2 + hstep, voffA);
            PG8_WAIT_L(8); PG8_BAR; PG8_WAIT_L(0); PG8_MMA(0, 0, At, B0); PG8_BAR; PG8_SCHED;
            PG8_LDB(B1, 1, 1); PG8_STAGE(PG8_SB(1, 0), b3, voffB);
            PG8_BAR; PG8_WAIT_L(0); PG8_MMA(0, 1, At, B1); PG8_BAR;
            PG8_LDA(At, 1, 1); PG8_STAGE(PG8_SA(1, 0), a3, voffA);
            PG8_BAR; PG8_WAIT_L(0); PG8_MMA(1, 0, At, B0); PG8_BAR; PG8_SCHED;
            PG8_STAGE(PG8_SB(1, 1), b3 + hstep, voffB);
            PG8_WAIT_V(6); PG8_BAR; PG8_MMA(1, 1, At, B1); PG8_BAR;
        }
        PG8_STAMP();
        if constexpr (!Epi::AFTER_DRAIN) { E(acc, cur, wr, wc, fr, fq); S.done(cur); }
        PG8_STAMP();
        if (!has_next) break;
#pragma unroll
        for (int a = 0; a < 2; ++a)
#pragma unroll
            for (int b = 0; b < 2; ++b)
#pragma unroll
                for (int m = 0; m < 4; ++m)
#pragma unroll
                    for (int n = 0; n < 2; ++n) acc[a][b][m][n] = (f32x4){0.f, 0.f, 0.f, 0.f};
        cur = nxt; cA = nA; cB = nB; ++ui;
    }
    PG8_WAIT_V(0);
    if (wr == 0) PG8_BAR;
    PG8_BAR;
    if constexpr (Epi::AFTER_DRAIN) { E.fused(acc, cur, wr, wc, fr, fq, lds, wid, lane); S.done(cur); }
    PG8_STAMP();
    if (STAMP && wid == 0) { stamps[lane] = lane < nts ? (((unsigned long long)(unsigned)ts_hi << 32) | (unsigned)ts_lo) : 0ull;
        if (lane == 62) stamps[62] = rt_entry; if (lane == 63) stamps[63] = (unsigned long long)wall_clock64(); }
#undef PG8_STAMP
#undef PG8_SA
#undef PG8_SB
#undef PG8_STAGE
#undef PG8_LDA
#undef PG8_LDB
#undef PG8_MMA
#undef PG8_WAIT_V
#undef PG8_WAIT_L
#undef PG8_BAR
#undef PG8_SCHED
}
}

using pg8::bf16_t; using pg8::bf16x8; using pg8::f32x4; using pg8::u32x4;
typedef unsigned u32x2 __attribute__((ext_vector_type(2)));
typedef float f32x2 __attribute__((ext_vector_type(2)));
#define LAS __attribute__((address_space(3)))

constexpr int MPR = 32768, MTOT = 32896, MPAD = 33024, PW = 2816;
constexpr int MODW = 18432, NMB = 136;
constexpr int ZC = 1536, SQ = 2048, SK = 2560, SV = 2688;
constexpr size_t O_CVP = 33685504, O_SP = 33759232, O_KP = 34807808, O_VP = 35069952, O_CVS = 35332096, O_SS = 36511744, O_KS = 53288960, O_VS = 57483264;
constexpr size_t LW_EL = 21233664;
constexpr size_t W_GU1 = 0, W_DN1 = 5767168, W_IN = 8650752, W_OUT = 11534336, W_GU2 = 12582912, W_DN2 = 18350080;
constexpr size_t WS_WT = 0;
constexpr size_t WS_ADA = 2 * LW_EL * 2;
constexpr size_t WS_QKM = WS_ADA;
constexpr size_t WS_GLE = WS_ADA + 16777216;
constexpr size_t WS_PAB = WS_GLE + 8192;
constexpr size_t WS_SC = WS_ADA + 37748736;
constexpr size_t WS_MOD = WS_SC + 524288;
constexpr size_t WS_H = WS_MOD + 10027008;
constexpr size_t WS_HID = WS_H + (size_t)MPAD * 1024 * 2;
constexpr size_t WS_UT = WS_HID + (size_t)MPAD * 2816 * 2;
constexpr size_t WS_W = WS_UT + 33554432;
constexpr size_t WS_QD = WS_W + 33554432;
constexpr size_t WS_KDT = WS_QD + 33554432;
constexpr size_t WS_END = WS_KDT + 33554432;
static_assert(WS_END <= 536870912ull, "workspace budget");
constexpr int LDS_BYTES = 139264;
constexpr int NPHASE = 26;
#ifndef MK_PH
#define MK_PH 0xffff
#endif

struct Params {
    const float* in[26];
    float* out;
    unsigned char* ws;
    int ph_lo, ph_hi, coop, pad;
};


__device__ __forceinline__ int ltid() { int t = threadIdx.x; asm volatile("" : "+v"(t)); return t; }
__device__ __forceinline__ int lbid() { int t = blockIdx.x; asm volatile("" : "+s"(t)); return t; }
__device__ __forceinline__ unsigned char* lws(const Params& p) { unsigned char* w = p.ws; asm volatile("" : "+s"(w)); return w; }
__device__ __forceinline__ float* lout(const Params& p) { float* w = p.out; asm volatile("" : "+s"(w)); return w; }

__device__ __forceinline__ float bf2f(unsigned short h) { return __uint_as_float(((unsigned)h) << 16); }
__device__ __forceinline__ unsigned short f2bf(float f) { unsigned u = __float_as_uint(f); u += 0x7fffu + ((u >> 16) & 1u); return (unsigned short)(u >> 16); }
typedef __bf16 bf16v2 __attribute__((ext_vector_type(2)));
__device__ __forceinline__ unsigned pk2(float lo, float hi) { f32x2 v = {lo, hi}; bf16v2 b = __builtin_convertvector(v, bf16v2); return __builtin_bit_cast(unsigned, b); }
__device__ __forceinline__ float lo_bf(unsigned u) { return __uint_as_float(u << 16); }
__device__ __forceinline__ float hi_bf(unsigned u) { return __uint_as_float(u & 0xffff0000u); }
__device__ __forceinline__ float silu_f(float x) { return x / (1.0f + __expf(-x)); }
__device__ __forceinline__ float wave_sum(float v) {
#pragma unroll
    for (int o = 32; o; o >>= 1) v += __shfl_xor(v, o);
    return v;
}
__device__ __forceinline__ float wave_max(float v) {
#pragma unroll
    for (int o = 32; o; o >>= 1) v = fmaxf(v, __shfl_xor(v, o));
    return v;
}
__device__ __forceinline__ bf16x8 mk8(unsigned a, unsigned b, unsigned c, unsigned d) { u32x4 w = {a, b, c, d}; return __builtin_bit_cast(bf16x8, w); }
__device__ __forceinline__ bf16x8 pack_frag(const f32x4& a, const f32x4& b) { return mk8(pk2(a[0], a[1]), pk2(a[2], a[3]), pk2(b[0], b[1]), pk2(b[2], b[3])); }
__device__ __forceinline__ bf16x8 rd_perm(const LAS unsigned char* p, int fq) {
    u32x2 lo = *(const LAS u32x2*)(p + 8 * fq), hi = *(const LAS u32x2*)(p + 32 + 8 * fq);
    return mk8(lo[0], lo[1], hi[0], hi[1]);
}
#define MFMA16(a, b, c) __builtin_amdgcn_mfma_f32_16x16x32_bf16((a), (b), (c), 0, 0, 0)

__device__ __forceinline__ void phase_prep(const Params& p, LAS unsigned char* lds) {
    const int tid = ltid();
    bf16_t* wt = (bf16_t*)(lws(p) + WS_WT); bf16_t* ada = (bf16_t*)(lws(p) + WS_ADA);
    LAS float* tile = (LAS float*)lds;
    for (int id = lbid(); id < 2 * 7488; id += gridDim.x) {
        const int l = id / 7488; int r = id % 7488;
        const float* src; bf16_t* dst; int K, Nsrc, map, kt, nt;
        if (r < 2304) { src = p.in[8] + (size_t)l * 1024 * 9216; Nsrc = 9216; dst = ada + (size_t)l * 9216 * 1024; K = 1024; map = 0; kt = r & 15; nt = r >> 4; }
        else if (r < 3712) { r -= 2304; src = p.in[11] + (size_t)l * 1024 * 5632; Nsrc = 5632; dst = wt + l * LW_EL + W_GU1; K = 1024; map = 1; kt = r & 15; nt = r >> 4; }
        else if (r < 4416) { r -= 3712; src = p.in[12] + (size_t)l * 2816 * 1024; Nsrc = 1024; dst = wt + l * LW_EL + W_DN1; K = 2816; map = 0; kt = r % 44; nt = r / 44; }
        else if (r < 5120) { r -= 4416; src = p.in[14] + (size_t)l * 1024 * 2824; Nsrc = 2824; dst = wt + l * LW_EL + W_IN; K = 1024; map = 2; kt = r & 15; nt = r >> 4; }
        else if (r < 5376) { r -= 5120; src = p.in[22] + (size_t)l * 1024 * 1024; Nsrc = 1024; dst = wt + l * LW_EL + W_OUT; K = 1024; map = 0; kt = r & 15; nt = r >> 4; }
        else if (r < 6784) { r -= 5376; src = p.in[24] + (size_t)l * 1024 * 5632; Nsrc = 5632; dst = wt + l * LW_EL + W_GU2; K = 1024; map = 1; kt = r & 15; nt = r >> 4; }
        else { r -= 6784; src = p.in[25] + (size_t)l * 2816 * 1024; Nsrc = 1024; dst = wt + l * LW_EL + W_DN2; K = 2816; map = 0; kt = r % 44; nt = r / 44; }
        const int k0 = kt * 64, n0 = nt * 64;
        {
            const int n = tid & 63, kk = tid >> 6, nn = n0 + n;
            const int sc = map == 0 ? nn : (map == 1 ? (((nn & 255) >> 7) * 2816 + (nn >> 8) * 128 + (nn & 127)) : (nn < 2048 ? nn : nn + 8));
#pragma unroll
            for (int i = 0; i < 8; ++i) tile[(kk + 8 * i) * 65 + n] = src[(size_t)(k0 + kk + 8 * i) * Nsrc + sc];
        }
        __syncthreads();
        {
            const int nn = tid >> 3, k8 = tid & 7;
            float v[8];
#pragma unroll
            for (int j = 0; j < 8; ++j) v[j] = tile[(8 * k8 + j) * 65 + nn];
            u32x4 w = {pk2(v[0], v[1]), pk2(v[2], v[3]), pk2(v[4], v[5]), pk2(v[6], v[7])};
            *(u32x4*)(dst + (size_t)(n0 + nn) * K + k0 + 8 * k8) = w;
        }
        __syncthreads();
    }
    bf16_t* sc = (bf16_t*)(lws(p) + WS_SC);
    for (int idx = lbid() * 512 + tid; idx < 256 * 1024; idx += gridDim.x * 512) {
        const int row = idx >> 10, col = idx & 1023; float v = 0.f;
        if (row < 8) v = silu_f(p.in[2][row * 1024 + col]); else if (row < NMB) v = silu_f(p.in[3][(row - 8) * 1024 + col]);
        sc[idx] = f2bf(v);
    }
    unsigned* hp = (unsigned*)(lws(p) + WS_H + (size_t)MTOT * 2048);
    for (int idx = lbid() * 512 + tid; idx < 65536; idx += gridDim.x * 512) hp[idx] = 0u;
}

__device__ __forceinline__ void phase_norm(const Params& p, LAS unsigned char* lds, int l, int which, const float* xp, const float* xs) {
    const int tid = ltid(), wid = tid >> 6, lane = tid & 63;
    const float* gv = p.in[which == 0 ? 10 : (which == 1 ? 13 : 23)] + l * 1024;
    const float* mod = (const float*)(lws(p) + WS_MOD);
    bf16_t* H = (bf16_t*)(lws(p) + WS_H);
    float* pab = (float*)(lws(p) + WS_PAB);
    LAS float* wab = (LAS float*)lds;
    __syncthreads();
    if (which == 1) {
        const float* win = p.in[14] + (size_t)l * 1024 * 2824 + 2048;
        for (int i = tid; i < 2048; i += 512) { const int k = i >> 1, hf = i & 1; f32x4 v = *(const f32x4*)(win + (size_t)k * 2824 + 4 * hf); *(LAS f32x4*)(wab + k * 8 + 4 * hf) = v; }
    }
    __syncthreads();
    f32x4 g4[4];
#pragma unroll
    for (int i = 0; i < 4; ++i) g4[i] = *(const f32x4*)(gv + 256 * i + 4 * lane);
    for (int r = lbid() * 8 + wid; r < MTOT; r += gridDim.x * 8) {
        const float* xr = r < MPR ? xp + (size_t)r * 1024 : xs + (size_t)(r - MPR) * 1024;
        const int mb = r < MPR ? (r >> 12) : 8 + (r - MPR);
        const float* mrow = mod + (size_t)mb * MODW + l * 9216 + (3 * which) * 1024;
        f32x4 x[4]; float ss = 0.f;
#pragma unroll
        for (int i = 0; i < 4; ++i) { x[i] = *(const f32x4*)(xr + 256 * i + 4 * lane); ss += x[i][0] * x[i][0] + x[i][1] * x[i][1] + x[i][2] * x[i][2] + x[i][3] * x[i][3]; }
        ss = wave_sum(ss);
        const float rstd = rsqrtf(ss * (1.0f / 1024.0f) + 1e-6f);
        float a0 = 0.f, a1 = 0.f, a2 = 0.f, a3 = 0.f, a4 = 0.f, a5 = 0.f, a6 = 0.f, a7 = 0.f;
#pragma unroll
        for (int i = 0; i < 4; ++i) {
            const f32x4 sh = *(const f32x4*)(mrow + 256 * i + 4 * lane), scl = *(const f32x4*)(mrow + 1024 + 256 * i + 4 * lane);
            f32x4 h;
#pragma unroll
            for (int e = 0; e < 4; ++e) h[e] = x[i][e] * rstd * g4[i][e] * (1.0f + scl[e]) + sh[e];
            u32x2 w = {pk2(h[0], h[1]), pk2(h[2], h[3])};
            *(u32x2*)(H + (size_t)r * 1024 + 256 * i + 4 * lane) = w;
            if (which == 1) {
#pragma unroll
                for (int e = 0; e < 4; ++e) {
                    const int k = 256 * i + 4 * lane + e;
                    const f32x4 w0 = *(const LAS f32x4*)(wab + k * 8), w1 = *(const LAS f32x4*)(wab + k * 8 + 4);
                    a0 += h[e] * w0[0]; a1 += h[e] * w0[1]; a2 += h[e] * w0[2]; a3 += h[e] * w0[3];
                    a4 += h[e] * w1[0]; a5 += h[e] * w1[1]; a6 += h[e] * w1[2]; a7 += h[e] * w1[3];
                }
            }
        }
        if (which == 1) {
            a0 = wave_sum(a0); a1 = wave_sum(a1); a2 = wave_sum(a2); a3 = wave_sum(a3); a4 = wave_sum(a4); a5 = wave_sum(a5); a6 = wave_sum(a6); a7 = wave_sum(a7);
            if (lane == 0) { f32x4 o0 = {a0, a1, a2, a3}, o1 = {a4, a5, a6, a7}; *(f32x4*)(pab + (size_t)r * 8) = o0; *(f32x4*)(pab + (size_t)r * 8 + 4) = o1; }
        }
    }
}

struct EpiAny {
    static constexpr bool PERM = true, AFTER_DRAIN = false;
    int kind; bf16_t* O; const float* xp; const float* xs; float* X; const float* gate; float s;
    __device__ __forceinline__ void operator()(const f32x4 (&acc)[2][2][4][2], const pg8::Unit& u, int wr, int wc, int fr, int fq) const {
        const int row0 = u.pm * 256 + wr * 64 + fr;
        if (kind == 0) {
            const int col0 = u.pn * 128 + wc * 32 + 8 * fq;
#pragma unroll
            for (int ai = 0; ai < 2; ++ai)
#pragma unroll
                for (int m = 0; m < 4; ++m) {
                    bf16_t* rowp = O + (size_t)(row0 + ai * 128 + m * 16) * 2816 + col0;
                    f32x4 v0, v1;
#pragma unroll
                    for (int e = 0; e < 4; ++e) { v0[e] = silu_f(acc[ai][0][m][0][e]) * acc[ai][1][m][0][e]; v1[e] = silu_f(acc[ai][0][m][1][e]) * acc[ai][1][m][1][e]; }
                    u32x4 w = {pk2(v0[0], v0[1]), pk2(v0[2], v0[3]), pk2(v1[0], v1[1]), pk2(v1[2], v1[3])};
                    *(u32x4*)rowp = w;
                }
        } else if (kind == 2) {
            const int col0 = u.pn * 256 + wc * 32 + 8 * fq;
#pragma unroll
            for (int ai = 0; ai < 2; ++ai)
#pragma unroll
                for (int m = 0; m < 4; ++m)
#pragma unroll
                    for (int bj = 0; bj < 2; ++bj) {
                        const f32x4 v0 = acc[ai][bj][m][0], v1 = acc[ai][bj][m][1];
                        u32x4 w = {pk2(v0[0], v0[1]), pk2(v0[2], v0[3]), pk2(v1[0], v1[1]), pk2(v1[2], v1[3])};
                        *(u32x4*)(O + (size_t)(row0 + ai * 128 + m * 16) * PW + col0 + bj * 128) = w;
                    }
        } else {
            const int col0 = u.pn * 256 + wc * 32 + 8 * fq;
            const int rlim = kind == 1 ? MTOT : NMB;
#pragma unroll
            for (int ai = 0; ai < 2; ++ai)
#pragma unroll
                for (int m = 0; m < 4; ++m) {
                    const int row = row0 + ai * 128 + m * 16;
                    if (row < rlim) {
                        const float* xr; const float* gr; float* o;
                        if (kind == 1) {
                            xr = row < MPR ? xp + (size_t)row * 1024 : xs + (size_t)(row - MPR) * 1024;
                            const int mb = row < MPR ? (row >> 12) : 8 + (row - MPR);
                            gr = gate + (size_t)mb * MODW; o = X + (size_t)row * 1024;
                        } else { xr = gate; gr = gate; o = X + (size_t)row * MODW; }
#pragma unroll
                        for (int bj = 0; bj < 2; ++bj)
#pragma unroll
                            for (int n = 0; n < 2; ++n) {
                                const int c = col0 + bj * 128 + n * 4;
                                const f32x4 gv = *(const f32x4*)(gr + c);
                                if (kind == 1) { const f32x4 xv = *(const f32x4*)(xr + c); *(f32x4*)(o + c) = xv + s * gv * acc[ai][bj][m][n]; }
                                else *(f32x4*)(o + c) = acc[ai][bj][m][n] + gv;
                            }
                    }
                }
        }
    }
};
template <class Epi> __device__ __forceinline__ void run_gemm(LAS unsigned char* lds, const bf16_t* A, const bf16_t* Bt, int Mg, int N, int K, const Epi& E) {
    pg8::Gemm g{A, Bt, Mg, N, K}; pg8::StaticOrder S; S.init(Mg, N, (int)gridDim.x, lbid());
    __syncthreads();
    pg8::gemm_phase<Epi, pg8::StaticOrder, false>(lds, g, S, E, nullptr);
    __syncthreads();
}

__device__ __forceinline__ void sample_dn(const Params& p, LAS unsigned char* lds, int l, int item) {
    const int tid = ltid(), wid = tid >> 6, lane = tid & 63;
    const int b = item >> 2, h = item & 3; const size_t r = (size_t)MPR + b;
    const bf16_t* P = (const bf16_t*)(lws(p) + WS_HID); bf16_t* MIX = (bf16_t*)(lws(p) + WS_H);
    const float* pab = (const float*)(lws(p) + WS_PAB);
    LAS float* yq = (LAS float*)lds; LAS float* yk = yq + 128; LAS float* yv = yk + 128; LAS float* red = yv + 128; LAS float* pk_ = red + 16; LAS float* pq_ = pk_ + 512;
    __syncthreads();
    if (tid < 384) {
        const int sel = tid >> 7, d = tid & 127, cc = sel * 512 + h * 128 + d;
        const float x = bf2f(P[r * PW + cc]);
        const float* sb = p.in[4] + ((size_t)(l * 128 + b) * 3) * 1536 + cc;
        const float b0 = sb[0], b1 = sb[1536], b2 = sb[3072];
        const float* cw = p.in[15] + (size_t)l * 4 * 1536 + cc;
        const float y = cw[0] * b0 + cw[1536] * b1 + cw[3072] * b2 + cw[4608] * x;
        float* co = lout(p) + O_CVS + ((size_t)(l * 128 + b) * 3) * 1536 + cc;
        co[0] = b1; co[1536] = b2; co[3072] = x;
        yq[sel * 128 + d] = silu_f(y);
    }
    __syncthreads();
    if (wid < 2) { const float a = yq[wid * 128 + lane], c2 = yq[wid * 128 + 64 + lane]; const float s = wave_sum(a * a + c2 * c2); if (lane == 0) red[wid] = s; }
    __syncthreads();
    const float rq = rsqrtf(red[0] + 1e-6f) * 0.08838834764831845f, rk = rsqrtf(red[1] + 1e-6f);
    const float pb = pab[r * 8 + h], pa = pab[r * 8 + 4 + h];
    const float beta = 1.0f / (1.0f + expf(-pb));
    const float xx = pa + p.in[17][l * 4 + h];
    const float g = -expf(p.in[16][l * 4 + h]) * (fmaxf(xx, 0.f) + log1pf(expf(-fabsf(xx))));
    const float eg = expf(g);
    const int e = tid & 127, dq = tid >> 7;
    const float* S0 = p.in[5] + ((size_t)(l * 128 + b) * 4 + h) * 16384;
    float s[32]; float ak = 0.f, aq = 0.f;
#pragma unroll
    for (int i = 0; i < 32; ++i) { const int d = 32 * dq + i; s[i] = S0[d * 128 + e]; ak += yk[d] * rk * s[i]; aq += yq[d] * rq * s[i]; }
    pk_[dq * 128 + e] = ak; pq_[dq * 128 + e] = aq;
    const float qk = wave_sum(yq[lane] * yk[lane] + yq[64 + lane] * yk[64 + lane]) * rq * rk;
    __syncthreads();
    const float kS = pk_[e] + pk_[128 + e] + pk_[256 + e] + pk_[384 + e], qS = pq_[e] + pq_[128 + e] + pq_[256 + e] + pq_[384 + e];
    const float vnew = beta * (yv[e] - eg * kS), o = eg * qS + qk * vnew;
    float* So = lout(p) + O_SS + ((size_t)(l * 128 + b) * 4 + h) * 16384;
#pragma unroll
    for (int i = 0; i < 32; ++i) { const int d = 32 * dq + i; So[d * 128 + e] = eg * s[i] + yk[d] * rk * vnew; }
    if (tid < 128) { const float ss = wave_sum(o * o); if (lane == 0) red[4 + wid] = ss; }
    __syncthreads();
    if (tid < 128) {
        const float rstd = rsqrtf((red[4] + red[5]) * (1.0f / 128.0f) + 1e-6f);
        const float z = bf2f(P[r * PW + ZC + h * 128 + e]);
        MIX[r * 1024 + h * 128 + e] = f2bf(o * rstd * p.in[18][l * 128 + e] * silu_f(z));
    }
}

__device__ __forceinline__ void sample_swa(const Params& p, LAS unsigned char* lds, int l, int b) {
    const int tid = ltid(), wid = tid >> 6, lane = tid & 63;
    const size_t r = (size_t)MPR + b;
    const bf16_t* P = (const bf16_t*)(lws(p) + WS_HID); bf16_t* MIX = (bf16_t*)(lws(p) + WS_H);
    LAS float* qs = (LAS float*)lds; LAS float* ks = qs + 512; LAS float* vs = ks + 128; LAS float* ps = vs + 128;
    __syncthreads();
    if (tid < 320) {
        const int head = tid >> 5, i = tid & 31;
        const float inv = exp2f(-(float)i * (13.287712379549449f / 32.0f));
        float rev = (16384.0f * inv) * 0.15915494309189535f; rev -= floorf(rev);
        const float sn = __builtin_amdgcn_sinf(rev), cs = __builtin_amdgcn_cosf(rev);
        const int col = (head < 8 ? SQ + head * 64 : SK + (head - 8) * 64) + i;
        const float x1 = bf2f(P[r * PW + col]), x2 = bf2f(P[r * PW + col + 32]);
        float ss = x1 * x1 + x2 * x2;
#pragma unroll
        for (int o = 1; o < 32; o <<= 1) ss += __shfl_xor(ss, o);
        const float rstd = rsqrtf(ss * (1.0f / 64.0f) + 1e-6f);
        const float* nw = p.in[head < 8 ? 19 : 20] + l * 64;
        const float y1 = x1 * rstd * nw[i], y2 = x2 * rstd * nw[i + 32];
        const float o1 = y1 * cs - y2 * sn, o2 = y2 * cs + y1 * sn;
        if (head < 8) { qs[head * 64 + i] = o1 * 0.125f; qs[head * 64 + i + 32] = o2 * 0.125f; }
        else { ks[(head - 8) * 64 + i] = o1; ks[(head - 8) * 64 + i + 32] = o2; }
    }
    if (tid >= 384) { const int c = tid - 384; vs[c] = bf2f(P[r * PW + SV + c]); }
    __syncthreads();
    const float* ck = p.in[6] + (size_t)(l * 128 + b) * 16384; const float* cv = p.in[7] + (size_t)(l * 128 + b) * 16384;
    float* ko = lout(p) + O_KS + (size_t)(l * 128 + b) * 16384; float* vo = lout(p) + O_VS + (size_t)(l * 128 + b) * 16384;
    for (int idx = tid; idx < 4096; idx += 512) {
        const int j = idx >> 5, c4 = idx & 31; f32x4 kv, vv;
        if (j < 127) { kv = *(const f32x4*)(ck + (j + 1) * 128 + 4 * c4); vv = *(const f32x4*)(cv + (j + 1) * 128 + 4 * c4); }
        else { kv = *(const LAS f32x4*)(ks + 4 * c4); vv = *(const LAS f32x4*)(vs + 4 * c4); }
        *(f32x4*)(ko + j * 128 + 4 * c4) = kv; *(f32x4*)(vo + j * 128 + 4 * c4) = vv;
    }
    {
        const int h = wid, hk = h >> 2; float s0 = 0.f, s1 = 0.f, s2 = 0.f;
        const float* k0 = ck + lane * 128 + hk * 64; const float* k1 = ck + (lane + 64) * 128 + hk * 64;
#pragma unroll
        for (int c4 = 0; c4 < 16; ++c4) {
            const f32x4 q4 = *(const LAS f32x4*)(qs + h * 64 + 4 * c4), a = *(const f32x4*)(k0 + 4 * c4), bb = *(const f32x4*)(k1 + 4 * c4), kk = *(const LAS f32x4*)(ks + hk * 64 + 4 * c4);
            s0 += q4[0] * a[0] + q4[1] * a[1] + q4[2] * a[2] + q4[3] * a[3];
            s1 += q4[0] * bb[0] + q4[1] * bb[1] + q4[2] * bb[2] + q4[3] * bb[3];
            s2 += q4[0] * kk[0] + q4[1] * kk[1] + q4[2] * kk[2] + q4[3] * kk[3];
        }
        const float sink = p.in[21][l * 8 + h];
        const float m = fmaxf(fmaxf(wave_max(fmaxf(s0, s1)), s2), sink);
        const float p0 = __expf(s0 - m), p1 = __expf(s1 - m), p2 = __expf(s2 - m);
        const float sum = wave_sum(p0 + p1) + p2 + __expf(sink - m);
        ps[h * 132 + lane] = p0; ps[h * 132 + 64 + lane] = p1;
        if (lane == 0) { ps[h * 132 + 128] = p2; ps[h * 132 + 129] = 1.0f / sum; }
    }
    __syncthreads();
    {
        const int h = wid, hk = h >> 2, d = lane; float o = 0.f;
        for (int j = 0; j < 128; ++j) o += ps[h * 132 + j] * cv[j * 128 + hk * 64 + d];
        o += ps[h * 132 + 128] * vs[hk * 64 + d]; o *= ps[h * 132 + 129];
        MIX[r * 1024 + 512 + h * 64 + d] = f2bf(o);
    }
}

__device__ __forceinline__ void swa_prep(const Params& p, int l) {
    const int tid = ltid(), wid = tid >> 6, lane = tid & 63, i = lane & 31;
    bf16_t* P = (bf16_t*)(lws(p) + WS_HID);
    const float inv = exp2f(-(float)i * (13.287712379549449f / 32.0f));
    const float qw1 = p.in[19][l * 64 + i], qw2 = p.in[19][l * 64 + i + 32], kw1 = p.in[20][l * 64 + i], kw2 = p.in[20][l * 64 + i + 32];
    for (int r = lbid() * 8 + wid; r < MPR; r += gridDim.x * 8) {
        const int t = r & 4095, b = r >> 12;
        float rev = ((float)t * inv) * 0.15915494309189535f; rev -= floorf(rev);
        const float sn = __builtin_amdgcn_sinf(rev), cs = __builtin_amdgcn_cosf(rev);
        bf16_t* pr = P + (size_t)r * PW;
#pragma unroll
        for (int k = 0; k < 5; ++k) {
            const int head = 2 * k + (lane >> 5);
            const int col = (head < 8 ? SQ + head * 64 : SK + (head - 8) * 64) + i;
            const float x1 = bf2f(pr[col]), x2 = bf2f(pr[col + 32]);
            float ss = x1 * x1 + x2 * x2;
#pragma unroll
            for (int o = 1; o < 32; o <<= 1) ss += __shfl_xor(ss, o);
            const float rstd = rsqrtf(ss * (1.0f / 64.0f) + 1e-6f);
            const float y1 = x1 * rstd * (head < 8 ? qw1 : kw1), y2 = x2 * rstd * (head < 8 ? qw2 : kw2);
            float o1 = y1 * cs - y2 * sn, o2 = y2 * cs + y1 * sn;
            if (head < 8) { o1 *= 0.125f; o2 *= 0.125f; }
            pr[col] = f2bf(o1); pr[col + 32] = f2bf(o2);
            if (head >= 8 && t >= 3968) { float* ko = lout(p) + O_KP + (((size_t)l * 8 + b) * 128 + (t - 3968)) * 128 + (head - 8) * 64 + i; ko[0] = o1; ko[32] = o2; }
        }
        if (t >= 3968) { float* vo = lout(p) + O_VP + (((size_t)l * 8 + b) * 128 + (t - 3968)) * 128; vo[lane] = bf2f(pr[SV + lane]); vo[lane + 64] = bf2f(pr[SV + 64 + lane]); }
    }
}

__device__ __forceinline__ void dn_chunk_prep(const Params& p, LAS unsigned char* lds, int l, int chid) {
    const int tid = ltid(), wid = tid >> 6, lane = tid & 63, fr = lane & 15, fq = lane >> 4;
    const int h = chid & 3, n = (chid >> 2) & 63, b = chid >> 8;
    const bf16_t* P = (const bf16_t*)(lws(p) + WS_HID);
    const float* pab = (const float*)(lws(p) + WS_PAB);
    bf16_t* UT = (bf16_t*)(lws(p) + WS_UT); bf16_t* Wg = (bf16_t*)(lws(p) + WS_W); bf16_t* QD = (bf16_t*)(lws(p) + WS_QD); bf16_t* KDT = (bf16_t*)(lws(p) + WS_KDT);
    bf16_t* QKM = (bf16_t*)(lws(p) + WS_QKM); float* GLE = (float*)(lws(p) + WS_GLE);
    LAS unsigned char* qn = lds; LAS unsigned char* kn = lds + 17408;
    LAS float* VB = (LAS float*)(lds + 34816); LAS float* KBG = (LAS float*)(lds + 67584); LAS float* AM = (LAS float*)(lds + 100352);
    LAS float* GC = (LAS float*)(lds + 116736); LAS float* BETA = GC + 64;
    const size_t rbase = (size_t)b * 4096 + n * 64;
    __syncthreads();
    float beta_t, gc_t;
    {
        const float* pr = pab + (rbase + lane) * 8; const float pb = pr[h], pa = pr[4 + h];
        beta_t = 1.0f / (1.0f + expf(-pb));
        const float xx = pa + p.in[17][l * 4 + h];
        float v = -expf(p.in[16][l * 4 + h]) * (fmaxf(xx, 0.f) + log1pf(expf(-fabsf(xx))));
#pragma unroll
        for (int o = 1; o < 64; o <<= 1) { const float t = __shfl_up(v, o); if (lane >= o) v += t; }
        gc_t = v;
        if (wid == 0) { GC[lane] = gc_t; BETA[lane] = beta_t; }
    }
    {
        const float* cw = p.in[15] + (size_t)l * 4 * 1536 + h * 128 + 2 * lane;
        float wq[4][2], wk[4][2], wv[4][2];
#pragma unroll
        for (int j = 0; j < 4; ++j)
#pragma unroll
            for (int e = 0; e < 2; ++e) { wq[j][e] = cw[j * 1536 + e]; wk[j][e] = cw[j * 1536 + 512 + e]; wv[j][e] = cw[j * 1536 + 1024 + e]; }
        float xq[11][2], xk[11][2], xv[11][2];
#pragma unroll
        for (int j = 0; j < 11; ++j) {
            const int ts = n * 64 + 8 * wid + j - 3;
            unsigned uq = 0u, uk = 0u, uv = 0u;
            if (ts >= 0) { const bf16_t* pr = P + ((size_t)b * 4096 + ts) * PW + h * 128 + 2 * lane; uq = *(const unsigned*)pr; uk = *(const unsigned*)(pr + 512); uv = *(const unsigned*)(pr + 1024); }
            xq[j][0] = lo_bf(uq); xq[j][1] = hi_bf(uq); xk[j][0] = lo_bf(uk); xk[j][1] = hi_bf(uk); xv[j][0] = lo_bf(uv); xv[j][1] = hi_bf(uv);
        }
#pragma unroll
        for (int i = 0; i < 8; ++i) {
            const int c = 8 * wid + i;
            float yq[2], yk[2], yv[2];
#pragma unroll
            for (int e = 0; e < 2; ++e) {
                yq[e] = silu_f(wq[0][e] * xq[i][e] + wq[1][e] * xq[i + 1][e] + wq[2][e] * xq[i + 2][e] + wq[3][e] * xq[i + 3][e]);
                yk[e] = silu_f(wk[0][e] * xk[i][e] + wk[1][e] * xk[i + 1][e] + wk[2][e] * xk[i + 2][e] + wk[3][e] * xk[i + 3][e]);
                yv[e] = silu_f(wv[0][e] * xv[i][e] + wv[1][e] * xv[i + 1][e] + wv[2][e] * xv[i + 2][e] + wv[3][e] * xv[i + 3][e]);
            }
            const float sq = wave_sum(yq[0] * yq[0] + yq[1] * yq[1]), sk = wave_sum(yk[0] * yk[0] + yk[1] * yk[1]);
            const float rq = rsqrtf(sq + 1e-6f) * 0.08838834764831845f, rk = rsqrtf(sk + 1e-6f);
            const float gcc = __shfl(gc_t, c), bc = __shfl(beta_t, c); const float eg = __expf(gcc);
            const float q0 = yq[0] * rq, q1 = yq[1] * rq, k0 = yk[0] * rk, k1 = yk[1] * rk;
            *(LAS unsigned*)(qn + c * 272 + 4 * lane) = pk2(q0, q1);
            *(LAS unsigned*)(kn + c * 272 + 4 * lane) = pk2(k0, k1);
            f32x2 vb = {yv[0] * bc, yv[1] * bc}, kb = {k0 * bc * eg, k1 * bc * eg};
            *(LAS f32x2*)(VB + c * 128 + 2 * lane) = vb; *(LAS f32x2*)(KBG + c * 128 + 2 * lane) = kb;
            *(unsigned*)(QD + ((size_t)chid * 64 + c) * 128 + 2 * lane) = pk2(q0 * eg, q1 * eg);
        }
    }
    __syncthreads();
#pragma unroll
    for (int it = 0; it < 4; ++it) {
        const int id = wid * 4 + it, isqk = id >> 4, ti = (id >> 2) & 3, tj = id & 3;
        f32x4 acc = {0.f, 0.f, 0.f, 0.f};
        if (ti >= tj) {
            const LAS unsigned char* bsrc = isqk ? qn : kn;
#pragma unroll
            for (int s = 0; s < 4; ++s) {
                const bf16x8 a = *(const LAS bf16x8*)(kn + (16 * tj + fr) * 272 + (32 * s + 8 * fq) * 2);
                const bf16x8 bb = *(const LAS bf16x8*)(bsrc + (16 * ti + fr) * 272 + (32 * s + 8 * fq) * 2);
                acc = MFMA16(a, bb, acc);
            }
        }
        const int i = 16 * ti + fr; const float gi = GC[i], bi = BETA[i];
        f32x4 val;
#pragma unroll
        for (int jj = 0; jj < 4; ++jj) {
            const int j = 16 * tj + 4 * fq + jj;
            const float v = acc[jj] * __expf(fminf(gi - GC[j], 0.f));
            val[jj] = isqk ? ((i >= j) ? v : 0.f) : ((i > j) ? v * bi : 0.f);
        }
        if (isqk) { u32x2 w = {pk2(val[0], val[1]), pk2(val[2], val[3])}; *(u32x2*)(QKM + ((size_t)chid * 64 + i) * 64 + 16 * tj + 4 * fq) = w; }
        else *(LAS f32x4*)(AM + i * 64 + 16 * tj + 4 * fq) = val;
    }
    __syncthreads();
    if (wid < 4) {
        const LAS float* mat = (wid < 2) ? VB : KBG; const int d = (wid & 1) * 64 + lane;
        float x[64];
#pragma unroll
        for (int c = 0; c < 64; ++c) x[c] = mat[c * 128 + d];
#pragma unroll
        for (int i = 1; i < 64; ++i) {
            float s0 = 0.f, s1 = 0.f, s2 = 0.f, s3 = 0.f;
#pragma unroll
            for (int j4 = 0; j4 < (i + 3) / 4; ++j4) {
                const f32x4 a = *(const LAS f32x4*)(AM + i * 64 + 4 * j4);
                s0 += a[0] * x[4 * j4]; s1 += a[1] * x[4 * j4 + 1]; s2 += a[2] * x[4 * j4 + 2]; s3 += a[3] * x[4 * j4 + 3];
            }
            x[i] -= (s0 + s1) + (s2 + s3);
        }
        if (wid < 2) {
            bf16_t* ut = UT + ((size_t)chid * 128 + d) * 64;
#pragma unroll
            for (int k = 0; k < 8; ++k) { u32x4 w = {pk2(x[8 * k], x[8 * k + 1]), pk2(x[8 * k + 2], x[8 * k + 3]), pk2(x[8 * k + 4], x[8 * k + 5]), pk2(x[8 * k + 6], x[8 * k + 7])}; *(u32x4*)(ut + 8 * k) = w; }
        } else {
            bf16_t* wp = Wg + (size_t)chid * 8192 + d;
#pragma unroll
            for (int c = 0; c < 64; ++c) wp[c * 128] = f2bf(x[c]);
        }
    } else {
        const int t2 = tid - 256, d = t2 & 127, hf = t2 >> 7; const float gl = GC[63];
#pragma unroll
        for (int c8 = 0; c8 < 4; ++c8) {
            float v[8];
#pragma unroll
            for (int e = 0; e < 8; ++e) { const int c = 32 * hf + 8 * c8 + e; v[e] = bf2f(*(const LAS bf16_t*)(kn + c * 272 + 2 * d)) * __expf(gl - GC[c]); }
            u32x4 w = {pk2(v[0], v[1]), pk2(v[2], v[3]), pk2(v[4], v[5]), pk2(v[6], v[7])};
            *(u32x4*)(KDT + ((size_t)chid * 128 + d) * 64 + 32 * hf + 8 * c8) = w;
        }
        if (t2 == 0) GLE[chid] = expf(gl);
    }
}

__device__ __forceinline__ void dn_scan(const Params& p, LAS unsigned char* lds, int l, int chain) {
    const int tid = ltid(), wid = tid >> 6, lane = tid & 63, fr = lane & 15, fq = lane >> 4;
    const int b = chain >> 2, h = chain & 3, n0 = 16 * wid;
    const bf16_t* UT = (const bf16_t*)(lws(p) + WS_UT); const bf16_t* Wg = (const bf16_t*)(lws(p) + WS_W); const bf16_t* QD = (const bf16_t*)(lws(p) + WS_QD);
    const bf16_t* KDT = (const bf16_t*)(lws(p) + WS_KDT); const bf16_t* QKM = (const bf16_t*)(lws(p) + WS_QKM); const float* GLE = (const float*)(lws(p) + WS_GLE);
    bf16_t* MIX = (bf16_t*)(lws(p) + WS_H);
    constexpr int OFF_W = 0, OFF_QD = 18432, OFF_KDT = 36864, OFF_QK = 57344, BUFSZ = 67584;
    f32x4 S[8];
#pragma unroll
    for (int t = 0; t < 8; ++t) S[t] = (f32x4){0.f, 0.f, 0.f, 0.f};
    u32x4 st[7]; u32x2 un[4], uc[4];
#define DN_LOAD(nn) do { const size_t ch_ = (size_t)((b * 64 + (nn)) * 4 + h); \
        const u32x4* g0_ = (const u32x4*)(Wg + ch_ * 8192); st[0] = g0_[tid]; st[1] = g0_[tid + 512]; \
        const u32x4* g1_ = (const u32x4*)(QD + ch_ * 8192); st[2] = g1_[tid]; st[3] = g1_[tid + 512]; \
        const u32x4* g2_ = (const u32x4*)(KDT + ch_ * 8192); st[4] = g2_[tid]; st[5] = g2_[tid + 512]; \
        const u32x4* g3_ = (const u32x4*)(QKM + ch_ * 4096); st[6] = g3_[tid]; \
        _Pragma("unroll") for (int t_ = 0; t_ < 4; ++t_) un[t_] = *(const u32x2*)(UT + (ch_ * 128 + n0 + fr) * 64 + 16 * t_ + 4 * fq); } while (0)
#define DN_WRITE(buf) do { LAS unsigned char* bb_ = lds + (buf) * BUFSZ; \
        *(LAS u32x4*)(bb_ + OFF_W + (tid >> 4) * 288 + (tid & 15) * 16) = st[0]; *(LAS u32x4*)(bb_ + OFF_W + (32 + (tid >> 4)) * 288 + (tid & 15) * 16) = st[1]; \
        *(LAS u32x4*)(bb_ + OFF_QD + (tid >> 4) * 288 + (tid & 15) * 16) = st[2]; *(LAS u32x4*)(bb_ + OFF_QD + (32 + (tid >> 4)) * 288 + (tid & 15) * 16) = st[3]; \
        *(LAS u32x4*)(bb_ + OFF_KDT + (tid >> 3) * 160 + (tid & 7) * 16) = st[4]; *(LAS u32x4*)(bb_ + OFF_KDT + (64 + (tid >> 3)) * 160 + (tid & 7) * 16) = st[5]; \
        *(LAS u32x4*)(bb_ + OFF_QK + (tid >> 3) * 160 + (tid & 7) * 16) = st[6]; } while (0)
    __syncthreads();
    DN_LOAD(0); DN_WRITE(0);
    __syncthreads();
    for (int n = 0; n < 64; ++n) {
#pragma unroll
        for (int t = 0; t < 4; ++t) uc[t] = un[t];
        if (n + 1 < 64) DN_LOAD(n + 1);
        const LAS unsigned char* base = lds + (n & 1) * BUFSZ;
        const float gle = GLE[(b * 64 + n) * 4 + h];
        bf16x8 sf[4];
#pragma unroll
        for (int s = 0; s < 4; ++s) sf[s] = pack_frag(S[2 * s], S[2 * s + 1]);
        f32x4 vn[4], oT[4];
#pragma unroll
        for (int t = 0; t < 4; ++t) {
            f32x4 a1 = {0.f, 0.f, 0.f, 0.f}, a2 = {0.f, 0.f, 0.f, 0.f};
#pragma unroll
            for (int s = 0; s < 4; ++s) {
                const bf16x8 wf = rd_perm(base + OFF_W + (16 * t + fr) * 288 + 64 * s, fq);
                a1 = MFMA16(wf, sf[s], a1);
                const bf16x8 qf = rd_perm(base + OFF_QD + (16 * t + fr) * 288 + 64 * s, fq);
                a2 = MFMA16(sf[s], qf, a2);
            }
            vn[t] = (f32x4){lo_bf(uc[t][0]) - a1[0], hi_bf(uc[t][0]) - a1[1], lo_bf(uc[t][1]) - a1[2], hi_bf(uc[t][1]) - a1[3]};
            oT[t] = a2;
        }
        bf16x8 vf[2];
        vf[0] = pack_frag(vn[0], vn[1]); vf[1] = pack_frag(vn[2], vn[3]);
#pragma unroll
        for (int t = 0; t < 4; ++t) {
#pragma unroll
            for (int s = 0; s < 2; ++s) { const bf16x8 kf = rd_perm(base + OFF_QK + (16 * t + fr) * 160 + 64 * s, fq); oT[t] = MFMA16(vf[s], kf, oT[t]); }
            const size_t row = (size_t)b * 4096 + n * 64 + 16 * t + fr;
            u32x2 w = {pk2(oT[t][0], oT[t][1]), pk2(oT[t][2], oT[t][3])};
            *(u32x2*)(MIX + row * 1024 + h * 128 + n0 + 4 * fq) = w;
        }
#pragma unroll
        for (int t = 0; t < 8; ++t) {
            f32x4 a = S[t] * gle;
#pragma unroll
            for (int s = 0; s < 2; ++s) { const bf16x8 kd = rd_perm(base + OFF_KDT + (16 * t + fr) * 160 + 64 * s, fq); a = MFMA16(kd, vf[s], a); }
            S[t] = a;
        }
        if (n + 1 < 64) DN_WRITE((n + 1) & 1);
        __syncthreads();
    }
#undef DN_LOAD
#undef DN_WRITE
    float* So = lout(p) + O_SP + ((size_t)(l * 8 + b) * 4 + h) * 16384;
#pragma unroll
    for (int t = 0; t < 8; ++t)
#pragma unroll
        for (int jj = 0; jj < 4; ++jj) So[(16 * t + 4 * fq + jj) * 128 + n0 + fr] = S[t][jj];
}

__device__ __forceinline__ void swa_attn_unit(const Params& p, LAS unsigned char* lds, int l, int unit) {
    const int tid = ltid(), wid = tid >> 6, lane = tid & 63, fr = lane & 15, fq = lane >> 4;
    const int hk = unit & 1, nb = (unit >> 1) & 31, b = unit >> 6;
    const bf16_t* P = (const bf16_t*)(lws(p) + WS_HID); bf16_t* MIX = (bf16_t*)(lws(p) + WS_H);
    LAS unsigned char* Ks = lds; LAS unsigned char* Vt = lds + 36864;
    __syncthreads();
#pragma unroll
    for (int it = 0; it < 4; ++it) {
        const int c = tid + 512 * it;
        { const int kj = c >> 3, c8 = c & 7; int tl = (nb - 1) * 128 + kj; if (tl < 0) tl += 128;
          const u32x4 kv = *(const u32x4*)(P + ((size_t)b * 4096 + tl) * PW + SK + hk * 64 + c8 * 8);
          *(LAS u32x4*)(Ks + kj * 144 + c8 * 16) = kv; }
        { const int kj = c & 255, c8 = c >> 8; int tl = (nb - 1) * 128 + kj; if (tl < 0) tl += 128;
          const u32x4 vv = *(const u32x4*)(P + ((size_t)b * 4096 + tl) * PW + SV + hk * 64 + c8 * 8);
#pragma unroll
          for (int e = 0; e < 8; ++e) *(LAS bf16_t*)(Vt + (c8 * 8 + e) * 528 + kj * 2) = (bf16_t)((e & 1) ? (vv[e >> 1] >> 16) : (vv[e >> 1] & 0xffffu)); }
    }
    __syncthreads();
    for (int it = 0; it < 4; ++it) {
        const int combo = wid * 4 + it, hq = combo >> 3, qt = combo & 7, head = hk * 4 + hq;
        const size_t tq = (size_t)b * 4096 + nb * 128 + 16 * qt + fr;
        bf16x8 qf[2];
#pragma unroll
        for (int ks = 0; ks < 2; ++ks) qf[ks] = *(const bf16x8*)(P + tq * PW + SQ + head * 64 + 32 * ks + 8 * fq);
        f32x4 sc[10];
#pragma unroll
        for (int u = 0; u < 9; ++u) {
            f32x4 a = {0.f, 0.f, 0.f, 0.f};
#pragma unroll
            for (int ks = 0; ks < 2; ++ks) { const bf16x8 kf = *(const LAS bf16x8*)(Ks + (16 * (qt + u) + fr) * 144 + (32 * ks + 8 * fq) * 2); a = MFMA16(kf, qf[ks], a); }
            sc[u] = a;
        }
        sc[9] = (f32x4){0.f, 0.f, 0.f, 0.f};
        const float sink = p.in[21][l * 8 + head];
        float m = sink;
#pragma unroll
        for (int u = 0; u < 9; ++u)
#pragma unroll
            for (int jj = 0; jj < 4; ++jj) {
                const int kk = 16 * u + 4 * fq + jj;
                const bool valid = (kk >= fr) && (kk <= fr + 128) && (nb > 0 || 16 * qt + kk >= 128);
                sc[u][jj] = valid ? sc[u][jj] : -__builtin_inff();
                m = fmaxf(m, sc[u][jj]);
            }
        m = fmaxf(m, __shfl_xor(m, 16)); m = fmaxf(m, __shfl_xor(m, 32));
        float sum = 0.f;
#pragma unroll
        for (int u = 0; u < 9; ++u)
#pragma unroll
            for (int jj = 0; jj < 4; ++jj) { const float pv = __expf(sc[u][jj] - m); sc[u][jj] = pv; sum += pv; }
        sum += __shfl_xor(sum, 16); sum += __shfl_xor(sum, 32);
        sum += __expf(sink - m);
        const float rinv = 1.0f / sum;
        f32x4 o[4];
#pragma unroll
        for (int dt = 0; dt < 4; ++dt) o[dt] = (f32x4){0.f, 0.f, 0.f, 0.f};
#pragma unroll
        for (int s = 0; s < 5; ++s) {
            const bf16x8 pf = pack_frag(sc[2 * s], sc[2 * s + 1]);
            const int kb = 16 * (qt + 2 * s), kb2 = (s < 4) ? kb + 16 : kb;
#pragma unroll
            for (int dt = 0; dt < 4; ++dt) {
                const u32x2 lo = *(const LAS u32x2*)(Vt + (16 * dt + fr) * 528 + (kb + 4 * fq) * 2), hi = *(const LAS u32x2*)(Vt + (16 * dt + fr) * 528 + (kb2 + 4 * fq) * 2);
                o[dt] = MFMA16(mk8(lo[0], lo[1], hi[0], hi[1]), pf, o[dt]);
            }
        }
#pragma unroll
        for (int dt = 0; dt < 4; ++dt) {
            u32x2 w = {pk2(o[dt][0] * rinv, o[dt][1] * rinv), pk2(o[dt][2] * rinv, o[dt][3] * rinv)};
            *(u32x2*)(MIX + tq * 1024 + 512 + head * 64 + 16 * dt + 4 * fq) = w;
        }
    }
}

__device__ __forceinline__ void phase_gnorm(const Params& p, int l) {
    const int tid = ltid(), wid = tid >> 6, lane = tid & 63;
    const bf16_t* P = (const bf16_t*)(lws(p) + WS_HID); bf16_t* MIX = (bf16_t*)(lws(p) + WS_H);
    const float* nw = p.in[18] + l * 128 + ((8 * lane) & 127);
    const f32x4 n0 = *(const f32x4*)nw, n1 = *(const f32x4*)(nw + 4);
    for (int r = lbid() * 8 + wid; r < MPR; r += gridDim.x * 8) {
        bf16_t* mp = MIX + (size_t)r * 1024 + 8 * lane;
        const u32x4 ov = *(const u32x4*)mp, zv = *(const u32x4*)(P + (size_t)r * PW + ZC + 8 * lane);
        float o[8], z[8];
#pragma unroll
        for (int e = 0; e < 4; ++e) { o[2 * e] = lo_bf(ov[e]); o[2 * e + 1] = hi_bf(ov[e]); z[2 * e] = lo_bf(zv[e]); z[2 * e + 1] = hi_bf(zv[e]); }
        float ss = 0.f;
#pragma unroll
        for (int e = 0; e < 8; ++e) ss += o[e] * o[e];
#pragma unroll
        for (int off = 1; off < 16; off <<= 1) ss += __shfl_xor(ss, off);
        const float rstd = rsqrtf(ss * (1.0f / 128.0f) + 1e-6f);
        float y[8];
#pragma unroll
        for (int e = 0; e < 8; ++e) y[e] = o[e] * rstd * (e < 4 ? n0[e] : n1[e - 4]) * silu_f(z[e]);
        u32x4 w = {pk2(y[0], y[1]), pk2(y[2], y[3]), pk2(y[4], y[5]), pk2(y[6], y[7])};
        *(u32x4*)mp = w;
    }
}

__global__ void __launch_bounds__(512, 2) hymba_megakernel(Params p) {
    extern __shared__ __attribute__((aligned(16))) unsigned char shm[];
    LAS unsigned char* lds = (LAS unsigned char*)shm;
    for (int ph = p.ph_lo; ph < p.ph_hi; ++ph) {
        const int tid = ltid();
        unsigned char* wsb = lws(p);
        bf16_t* wt = (bf16_t*)(wsb + WS_WT);
        bf16_t* H = (bf16_t*)(wsb + WS_H); bf16_t* HID = (bf16_t*)(wsb + WS_HID);
        float* MOD = (float*)(wsb + WS_MOD);
        float* X = lout(p);
        const int l = ph < 2 ? 0 : (ph - 2) / 12, sub = ph < 2 ? -1 : (ph - 2) % 12;
        const bool first = (l == 0 && sub < 3);
        const float* xp = first ? p.in[0] : X; const float* xs = first ? p.in[1] : X + (size_t)MPR * 1024;
        const bf16_t* wl = wt + l * LW_EL;
        const bool is_gemm = (ph == 1) || sub == 1 || sub == 2 || sub == 4 || sub == 8 || sub == 10 || sub == 11;
        if (is_gemm) {
            if (MK_PH & 2) {
                EpiAny E{}; const bf16_t* A = H; const bf16_t* Bt; int Mg = MPAD, N, K = 1024;
                E.xp = xp; E.xs = xs; E.X = X; E.O = HID; E.s = 0.5f; E.gate = MOD;
                if (ph == 1) { E.kind = 3; A = (const bf16_t*)(lws(p) + WS_SC); Bt = (const bf16_t*)(lws(p) + WS_ADA); Mg = 256; N = MODW; E.X = MOD; E.gate = p.in[9]; }
                else if (sub == 1) { E.kind = 0; Bt = wl + W_GU1; N = 5632; }
                else if (sub == 10) { E.kind = 0; Bt = wl + W_GU2; N = 5632; }
                else if (sub == 2) { E.kind = 1; A = HID; Bt = wl + W_DN1; N = 1024; K = 2816; E.gate = MOD + l * 9216 + 2 * 1024; }
                else if (sub == 11) { E.kind = 1; A = HID; Bt = wl + W_DN2; N = 1024; K = 2816; E.gate = MOD + l * 9216 + 8 * 1024; }
                else if (sub == 8) { E.kind = 1; Bt = wl + W_OUT; N = 1024; E.s = 1.0f; E.gate = MOD + l * 9216 + 5 * 1024; }
                else { E.kind = 2; Bt = wl + W_IN; N = 2816; }
                run_gemm(lds, A, Bt, Mg, N, K, E);
            }
        }
        else if (ph == 0) { if (MK_PH & 1) phase_prep(p, lds); }
        else if (sub == 0 || sub == 3 || sub == 9) { if (MK_PH & 4) phase_norm(p, lds, l, sub == 0 ? 0 : (sub == 3 ? 1 : 2), xp, xs); }
        else if (sub == 5) {
            for (int it = lbid(); it < 640; it += gridDim.x) { if (MK_PH & 8) { if (it < 512) sample_dn(p, lds, l, it); else sample_swa(p, lds, l, it - 512); } }
            if (MK_PH & 16) swa_prep(p, l);
            for (int ch = lbid(); ch < 2048; ch += gridDim.x) { if (MK_PH & 32) dn_chunk_prep(p, lds, l, ch); }
            for (int idx = lbid() * 512 + tid; idx < 8 * 3 * 1536; idx += gridDim.x * 512) {
                const int cc = idx % 1536, j = (idx / 1536) % 3, b = idx / 4608;
                lout(p)[O_CVP + (size_t)l * 36864 + idx] = bf2f(HID[((size_t)b * 4096 + 4093 + j) * PW + cc]);
            }
        }
        else if (sub == 6) {
            const int G = gridDim.x;
            if (G > 32) { if (lbid() < 32) { if (MK_PH & 64) dn_scan(p, lds, l, lbid()); } else for (int u = lbid() - 32; u < 512; u += G - 32) { if (MK_PH & 128) swa_attn_unit(p, lds, l, u); } }
            else { for (int c = lbid(); c < 32; c += G) { if (MK_PH & 64) dn_scan(p, lds, l, c); } for (int u = lbid(); u < 512; u += G) { if (MK_PH & 128) swa_attn_unit(p, lds, l, u); } }
        }
        else if (sub == 7) { if (MK_PH & 256) phase_gnorm(p, l); }
        if (ph + 1 < p.ph_hi) { if (p.coop) cg::this_grid().sync(); }
    }
}

#ifndef MK_MULTI
#define MK_MULTI 0
#endif
extern "C" void kernel_launch(void* const* d_in, const int* in_sizes, int n_in, void* d_out, int out_size, void* d_ws, size_t ws_size, hipStream_t stream) {
    static int grid = 0;
    if (grid == 0) {
        if (n_in != 26 || ws_size < WS_END) { fprintf(stderr, "kernel_launch: n_in %d ws %zu (need %zu)\n", n_in, ws_size, (size_t)WS_END); grid = -1; return; }
        int dev = 0, cus = 0, per_cu = 0;
        hipGetDevice(&dev);
        hipDeviceGetAttribute(&cus, hipDeviceAttributeMultiprocessorCount, dev);
        if (hipFuncSetAttribute((const void*)hymba_megakernel, hipFuncAttributeMaxDynamicSharedMemorySize, LDS_BYTES) != hipSuccess) { fprintf(stderr, "kernel_launch: hipFuncSetAttribute failed\n"); grid = -1; return; }
        if (hipOccupancyMaxActiveBlocksPerMultiprocessor(&per_cu, (const void*)hymba_megakernel, 512, LDS_BYTES) != hipSuccess || per_cu < 1) { fprintf(stderr, "kernel_launch: occupancy query says %d\n", per_cu); per_cu = 1; }
        (void)hipGetLastError();
        grid = cus * 1;
        if (grid < 1) grid = 256;
    }
    if (grid < 0) return;
    Params p{};
    for (int i = 0; i < 26; ++i) p.in[i] = (const float*)d_in[i];
    p.out = (float*)d_out; p.ws = (unsigned char*)d_ws;
#if MK_MULTI
    for (int ph = 0; ph < NPHASE; ++ph) { p.ph_lo = ph; p.ph_hi = ph + 1; p.coop = 0; hipLaunchKernelGGL(hymba_megakernel, dim3(grid), dim3(512), LDS_BYTES, stream, p); }
#else
    p.ph_lo = 0; p.ph_hi = NPHASE; p.coop = 1;
    void* args[] = {&p};
    hipError_t e = hipLaunchCooperativeKernel((const void*)hymba_megakernel, dim3(grid), dim3(512), args, LDS_BYTES, stream);
    if (e != hipSuccess) fprintf(stderr, "cooperative launch failed: %s (grid %d)\n", hipGetErrorString(e), grid);
#endif
}
```

```cpp
#include <hip/hip_runtime.h>
#include <hip/hip_cooperative_groups.h>
#include <cstdio>
namespace cg = cooperative_groups;
#include <hip/hip_runtime.h>
namespace pg8 {
#define PG8_LAS __attribute__((address_space(3)))
typedef unsigned short bf16_t;
typedef short bf16x8 __attribute__((ext_vector_type(8)));
typedef float f32x4 __attribute__((ext_vector_type(4)));
typedef unsigned u32x4 __attribute__((ext_vector_type(4)));
constexpr int BM = 256, BK = 64, HALF = 128, HTB = HALF * BK * 2  , STAGE_BYTES = 8 * HTB, NXCD = 8, WGM = 8;

__host__ __device__ __forceinline__ int lds_byte(int r, int c) { const int st = (r >> 4) * 2 + (c >> 5), rr = r & 15, cc = c & 31, ob = rr * 64 + cc * 2; return st * 1024 + (ob ^ (((ob >> 9) & 1) << 5)); }
__host__ __device__ __forceinline__ void stage_rc(int b, int& R, int& C) { const int st = b / 1024, sb = b % 1024, swz = sb ^ (((sb >> 9) & 1) << 5); R = (st >> 1) * 16 + swz / 64; C = (st & 1) * 32 + (swz % 64) / 2; }
__host__ __device__ __forceinline__ int perm32(int rho) { const int n = rho >> 4, i = rho & 15; return 8 * (i >> 2) + 4 * n + (i & 3); }

struct Unit { int pm, pn; };
struct Gemm { const bf16_t* A; const bf16_t* Bt; int M, N, K; };

struct StaticOrder {
    int nM, nN, nwg, G, c;
    __host__ __device__ void init(int M, int N, int G_, int c_) { nM = M / BM; nN = N / BM; nwg = nM * nN; G = G_; c = c_; }
    __host__ __device__ bool next(int i, Unit& u) const {
        const long L = (long)i * G + c; if (L >= nwg) return false;
        int wgid = (int)L; { const int q = nwg / NXCD, r = nwg % NXCD, xcd = wgid % NXCD, off = wgid / NXCD; wgid = (xcd < r ? xcd * (q + 1) : r * (q + 1) + (xcd - r) * q) + off; }
        const int nig = WGM * nN, gid = wgid / nig, fm = gid * WGM, gsz = (nM - fm) < WGM ? (nM - fm) : WGM;
        u.pm = fm + ((wgid % nig) % gsz); u.pn = (wgid % nig) / gsz; return true;
    }
    __device__ __forceinline__ void a_ready(const Unit&) const {}
    __device__ __forceinline__ void done(const Unit&) const {}
};
__device__ __forceinline__ unsigned cvt_pk_bf16(float lo, float hi) { unsigned r; asm volatile("v_cvt_pk_bf16_f32 %0, %1, %2" : "=v"(r) : "v"(lo), "v"(hi)); return r; }
template <class Epi, class Sched, bool STAMP = false>
__device__ __forceinline__ void gemm_phase(PG8_LAS unsigned char* lds, const Gemm g, const Sched& S, const Epi& E, unsigned long long* stamps) {
    int tid_ = threadIdx.x; asm volatile("" : "+v"(tid_)); const int tid = tid_, wid = __builtin_amdgcn_readfirstlane(tid >> 6), lane = tid & 63, wr = wid >> 2, wc = wid & 3, fr = lane & 15, fq = lane >> 4;
    const int K = g.K, nt = K / BK;
    int ts_lo = 0, ts_hi = 0, nts = 0; const unsigned long long rt_entry = STAMP ? (unsigned long long)wall_clock64() : 0ull;
#define PG8_STAMP() do { if (STAMP && wid == 0 && nts < 64) { const unsigned long long _c = (unsigned long long)clock64(); \
        ts_lo = (lane == nts) ? (int)(unsigned)_c : ts_lo; ts_hi = (lane == nts) ? (int)(unsigned)(_c >> 32) : ts_hi; ++nts; } } while (0)
    PG8_STAMP();
    unsigned voffA[2], voffB[2];
#pragma unroll
    for (int i = 0; i < 2; ++i) { int R, C; stage_rc(tid * 16 + i * 8192, R, C); const int Rb = Epi::PERM ? ((R & ~31) + perm32(R & 31)) : R;
        voffA[i] = (unsigned)(R * K + C) * 2u; voffB[i] = (unsigned)(Rb * K + C) * 2u; }
    const size_t kstep = (size_t)(BK * 2);
    const size_t hstep = (size_t)HALF * K * 2;
    const size_t tstep = 2 * hstep;
    const unsigned ldsw = (unsigned)wid * 1024u;
    const int aoff = lds_byte(wr * 64 + fr, fq * 8), boff = lds_byte(wc * 32 + fr, fq * 8);
#define PG8_SA(b, h) (((b) * 2 + (h)) * HTB)
#define PG8_SB(b, h) ((4 + (b) * 2 + (h)) * HTB)
#define PG8_STAGE(bufoff, gbase, voff) do { _Pragma("unroll") for (int _i = 0; _i < 2; ++_i) \
        __builtin_amdgcn_global_load_lds((const unsigned*)((const char*)(gbase) + (voff)[_i]), (PG8_LAS unsigned*)(lds + (bufoff) + ldsw + _i * 8192), 16, 0, 0); } while (0)
#define PG8_LDA(dst, b, h) do { _Pragma("unroll") for (int m = 0; m < 4; ++m) _Pragma("unroll") for (int k = 0; k < 2; ++k) dst[m][k] = *(const PG8_LAS bf16x8*)(lds + PG8_SA(b, h) + aoff + m * 2048 + k * 1024); } while (0)
#define PG8_LDB(dst, b, h) do { _Pragma("unroll") for (int n = 0; n < 2; ++n) _Pragma("unroll") for (int k = 0; k < 2; ++k) dst[n][k] = *(const PG8_LAS bf16x8*)(lds + PG8_SB(b, h) + boff + n * 2048 + k * 1024); } while (0)
#define PG8_MMA(ai, bj, At, Bt) do { __builtin_amdgcn_s_setprio(1); _Pragma("unroll") for (int m = 0; m < 4; ++m) _Pragma("unroll") for (int n = 0; n < 2; ++n) _Pragma("unroll") for (int k = 0; k < 2; ++k) \
        acc[ai][bj][m][n] = __builtin_amdgcn_mfma_f32_16x16x32_bf16(Bt[n][k], At[m][k], acc[ai][bj][m][n], 0, 0, 0); __builtin_amdgcn_s_setprio(0); } while (0)
#define PG8_WAIT_V(n) asm volatile("s_waitcnt vmcnt(" #n ")" ::: "memory")
#define PG8_WAIT_L(n) asm volatile("s_waitcnt lgkmcnt(" #n ")" ::: "memory")
#define PG8_BAR __builtin_amdgcn_s_barrier()
#define PG8_SCHED __builtin_amdgcn_sched_barrier(0)
    Unit cur, nxt; int ui = 0;
    if (!S.next(0, cur)) return;
    f32x4 acc[2][2][4][2];
#pragma unroll
    for (int a = 0; a < 2; ++a)
#pragma unroll
        for (int b = 0; b < 2; ++b)
#pragma unroll
            for (int m = 0; m < 4; ++m)
#pragma unroll
                for (int n = 0; n < 2; ++n) acc[a][b][m][n] = (f32x4){0.f, 0.f, 0.f, 0.f};
    bf16x8 At[4][2], B0[2][2], B1[2][2];
    const char* cA = (const char*)g.A + (size_t)cur.pm * tstep; const char* cB = (const char*)g.Bt + (size_t)cur.pn * tstep;
    S.a_ready(cur);
    PG8_STAGE(PG8_SB(0, 0), cB, voffB); PG8_STAGE(PG8_SA(0, 0), cA, voffA); PG8_STAGE(PG8_SB(0, 1), cB + hstep, voffB); PG8_STAGE(PG8_SA(0, 1), cA + hstep, voffA);
    if (wr == 1) PG8_BAR;
    PG8_WAIT_V(4); PG8_BAR;
    PG8_STAGE(PG8_SB(1, 0), cB + kstep, voffB); PG8_STAGE(PG8_SA(1, 0), cA + kstep, voffA); PG8_STAGE(PG8_SB(1, 1), cB + hstep + kstep, voffB);
    PG8_WAIT_V(6); PG8_BAR;
    PG8_STAMP();
    for (;;) {
        const bool has_next = S.next(ui + 1, nxt);
        const char* nA = has_next ? (const char*)g.A + (size_t)nxt.pm * tstep : cA; const char* nB = has_next ? (const char*)g.Bt + (size_t)nxt.pn * tstep : cB;
        for (int t = 0; t < nt; t += 2) {
            const bool last = (t == nt - 2);
            const char* a1 = cA + (size_t)(t + 1) * kstep;
            const char* a2 = last ? nA : cA + (size_t)(t + 2) * kstep; const char* b2 = last ? nB : cB + (size_t)(t + 2) * kstep;
            const char* a3 = a2 + kstep; const char* b3 = b2 + kstep;
            if (last && has_next) S.a_ready(nxt);
            PG8_LDB(B0, 0, 0); PG8_SCHED; PG8_LDA(At, 0, 0); PG8_STAGE(PG8_SA(1, 1), a1 + hstep, voffA);
            PG8_WAIT_L(8); PG8_BAR; PG8_WAIT_L(0); PG8_MMA(0, 0, At, B0); PG8_BAR; PG8_SCHED;
            PG8_LDB(B1, 0, 1); PG8_STAGE(PG8_SB(0, 0), b2, voffB);
            PG8_BAR; PG8_WAIT_L(0); PG8_MMA(0, 1, At, B1); PG8_BAR;
            PG8_LDA(At, 0, 1); PG8_STAGE(PG8_SA(0, 0), a2, voffA);
            PG8_BAR; PG8_WAIT_L(0); PG8_MMA(1, 0, At, B0); PG8_BAR; PG8_SCHED;
            PG8_STAGE(PG8_SB(0, 1), b2 + hstep, voffB);
            PG8_WAIT_V(6); PG8_BAR; PG8_MMA(1, 1, At, B1); PG8_BAR;
            PG8_LDB(B0, 1, 0); PG8_SCHED; PG8_LDA(At, 1, 0); PG8_STAGE(PG8_SA(0, 1), a2 + hstep, voffA);
            PG8_WAIT_L(8); PG8_BAR; PG8_WAIT_L(0); PG8_MMA(0, 0, At, B0); PG8_BAR; PG8_SCHED;
            PG8_LDB(B1, 1, 1); PG8_STAGE(PG8_SB(1, 0), b3, voffB);
            PG8_BAR; PG8_WAIT_L(0); PG8_MMA(0, 1, At, B1); PG8_BAR;
            PG8_LDA(At, 1, 1); PG8_STAGE(PG8_SA(1, 0), a3, voffA);
            PG8_BAR; PG8_WAIT_L(0); PG8_MMA(1, 0, At, B0); PG8_BAR; PG8_SCHED;
            PG8_STAGE(PG8_SB(1, 1), b3 + hstep, voffB);
            PG8_WAIT_V(6); PG8_BAR; PG8_MMA(1, 1, At, B1); PG8_BAR;
        }
        PG8_STAMP();
        if constexpr (!Epi::AFTER_DRAIN) { E(acc, cur, wr, wc, fr, fq); S.done(cur); }
        PG8_STAMP();
        if (!has_next) break;
#pragma unroll
        for (int a = 0; a < 2; ++a)
#pragma unroll
            for (int b = 0; b < 2; ++b)
#pragma unroll
                for (int m = 0; m < 4; ++m)
#pragma unroll
                    for (int n = 0; n < 2; ++n) acc[a][b][m][n] = (f32x4){0.f, 0.f, 0.f, 0.f};
        cur = nxt; cA = nA; cB = nB; ++ui;
    }
    PG8_WAIT_V(0);
    if (wr == 0) PG8_BAR;
    PG8_BAR;
    if constexpr (Epi::AFTER_DRAIN) { E.fused(acc, cur, wr, wc, fr, fq, lds, wid, lane); S.done(cur); }
    PG8_STAMP();
    if (STAMP && wid == 0) { stamps[lane] = lane < nts ? (((unsigned long long)(unsigned)ts_hi << 32) | (unsigned)ts_lo) : 0ull;
        if (lane == 62) stamps[62] = rt_entry; if (lane == 63) stamps[63] = (unsigned long long)wall_clock64(); }
#undef PG8_STAMP
#undef PG8_SA
#undef PG8_SB
#undef PG8_STAGE
#undef PG8_LDA
#undef PG8_LDB
#undef PG8_MMA
#undef PG8_WAIT_V
#undef PG8_WAIT_L
#undef PG8_BAR
#undef PG8_SCHED
}
}

using pg8::bf16_t; using pg8::bf16x8; using pg8::f32x4; using pg8::u32x4;
typedef unsigned u32x2 __attribute__((ext_vector_type(2)));
typedef float f32x2 __attribute__((ext_vector_type(2)));
#define LAS __attribute__((address_space(3)))

constexpr int MPR = 32768, MTOT = 32896, MPAD = 33024, PW = 2816;
constexpr int MODW = 18432, NMB = 136;
constexpr int ZC = 1536, SQ = 2048, SK = 2560, SV = 2688;
constexpr size_t O_CVP = 33685504, O_SP = 33759232, O_KP = 34807808, O_VP = 35069952, O_CVS = 35332096, O_SS = 36511744, O_KS = 53288960, O_VS = 57483264;
constexpr size_t LW_EL = 21233664;
constexpr size_t W_GU1 = 0, W_DN1 = 5767168, W_IN = 8650752, W_OUT = 11534336, W_GU2 = 12582912, W_DN2 = 18350080;
constexpr size_t WS_WT = 0;
constexpr size_t WS_ADA = 2 * LW_EL * 2;
constexpr size_t WS_QKM = WS_ADA;
constexpr size_t WS_GLE = WS_ADA + 16777216;
constexpr size_t WS_PAB = WS_GLE + 8192;
constexpr size_t WS_SC = WS_ADA + 37748736;
constexpr size_t WS_MOD = WS_SC + 524288;
constexpr size_t WS_H = WS_MOD + 10027008;
constexpr size_t WS_HID = WS_H + (size_t)MPAD * 1024 * 2;
constexpr size_t WS_UT = WS_HID + (size_t)MPAD * 2816 * 2;
constexpr size_t WS_W = WS_UT + 33554432;
constexpr size_t WS_QD = WS_W + 33554432;
constexpr size_t WS_KDT = WS_QD + 33554432;
constexpr size_t WS_END = WS_KDT + 33554432;
constexpr size_t WS_BAR = WS_END;
constexpr size_t WS_TOTAL = WS_BAR + 16384;
static_assert(WS_TOTAL <= 536870912ull, "workspace budget");
constexpr int LDS_BYTES = 147456;
constexpr int LDS_XB = LDS_BYTES - 16;
constexpr int NPHASE = 26;

struct Params {
    const float* in[26];
    float* out;
    unsigned char* ws;
    int ph_lo, ph_hi, coop, pad;
};


__device__ __forceinline__ int ltid() { int t = threadIdx.x; asm volatile("" : "+v"(t)); return t; }
__device__ __forceinline__ int lbid() { int t = blockIdx.x; asm volatile("" : "+s"(t)); return t; }
__device__ __forceinline__ size_t lzero() { size_t z = 0; asm volatile("" : "+s"(z)); return z; }
__device__ __forceinline__ unsigned char* lws(const Params& p) { return p.ws + lzero(); }
__device__ __forceinline__ float* lout(const Params& p) { return p.out + lzero(); }

__device__ __forceinline__ float bf2f(unsigned short h) { return __uint_as_float(((unsigned)h) << 16); }
__device__ __forceinline__ unsigned short f2bf(float f) { unsigned u = __float_as_uint(f); u += 0x7fffu + ((u >> 16) & 1u); return (unsigned short)(u >> 16); }
typedef __bf16 bf16v2 __attribute__((ext_vector_type(2)));
__device__ __forceinline__ unsigned pk2(float lo, float hi) { f32x2 v = {lo, hi}; bf16v2 b = __builtin_convertvector(v, bf16v2); return __builtin_bit_cast(unsigned, b); }
__device__ __forceinline__ float lo_bf(unsigned u) { return __uint_as_float(u << 16); }
__device__ __forceinline__ float hi_bf(unsigned u) { return __uint_as_float(u & 0xffff0000u); }
__device__ __forceinline__ float silu_f(float x) { return x * __builtin_amdgcn_rcpf(1.0f + __expf(-x)); }
template <int CTRL> __device__ __forceinline__ float dpp_f(float v) { return __builtin_bit_cast(float, __builtin_amdgcn_update_dpp(0, __builtin_bit_cast(int, v), CTRL, 0xf, 0xf, true)); }
__device__ __forceinline__ float row16_sum(float v) { v += dpp_f<0xB1>(v); v += dpp_f<0x4E>(v); v += dpp_f<0x141>(v); v += dpp_f<0x140>(v); return v; }
__device__ __forceinline__ float wave_sum(float v) {
    v = row16_sum(v);
    const float a = __builtin_bit_cast(float, __builtin_amdgcn_readlane(__builtin_bit_cast(int, v), 15)), b = __builtin_bit_cast(float, __builtin_amdgcn_readlane(__builtin_bit_cast(int, v), 31));
    const float c = __builtin_bit_cast(float, __builtin_amdgcn_readlane(__builtin_bit_cast(int, v), 47)), d = __builtin_bit_cast(float, __builtin_amdgcn_readlane(__builtin_bit_cast(int, v), 63));
    return (a + b) + (c + d);
}
__device__ __forceinline__ float wave_max(float v) {
#pragma unroll
    for (int o = 32; o; o >>= 1) v = fmaxf(v, __shfl_xor(v, o));
    return v;
}
__device__ __forceinline__ bf16x8 mk8(unsigned a, unsigned b, unsigned c, unsigned d) { u32x4 w = {a, b, c, d}; return __builtin_bit_cast(bf16x8, w); }
__device__ __forceinline__ bf16x8 pack_frag(const f32x4& a, const f32x4& b) { return mk8(pk2(a[0], a[1]), pk2(a[2], a[3]), pk2(b[0], b[1]), pk2(b[2], b[3])); }
__device__ __forceinline__ bf16x8 rd_perm(const LAS unsigned char* p, int fq) {
    u32x2 lo = *(const LAS u32x2*)(p + 8 * fq), hi = *(const LAS u32x2*)(p + 32 + 8 * fq);
    return mk8(lo[0], lo[1], hi[0], hi[1]);
}
__device__ __forceinline__ int kpos(int k) { const int kk = k & 31; return (k & ~31) + ((kk & 12) << 1) + ((kk & 16) >> 2) + (kk & 3); }
#define LDS_BARRIER() do { asm volatile("s_waitcnt lgkmcnt(0)" ::: "memory"); __builtin_amdgcn_s_barrier(); asm volatile("" ::: "memory"); } while (0)
#define SCHED_FENCE() __builtin_amdgcn_sched_barrier(0)
#define MFMA16(a, b, c) __builtin_amdgcn_mfma_f32_16x16x32_bf16((a), (b), (c), 0, 0, 0)

#define XB_TMO      128
#define XB_XCNT(j)  (256  + 64 * (j))
#define XB_XSUB(j)  (1280 + 64 * (j))
#define XB_XGEN(j)  (2304 + 64 * (j))
#define XB_TOP      3328
#define XB_TOPGEN   3392
#define XCD_BAR_WORDS 3456
#define XB_SPIN_CAP (1u << 18)

__device__ __forceinline__ unsigned xb_ld(unsigned* p)              { return __hip_atomic_load(p, __ATOMIC_RELAXED, __HIP_MEMORY_SCOPE_AGENT); }
__device__ __forceinline__ unsigned xb_add(unsigned* p, unsigned v) { return __hip_atomic_fetch_add(p, v, __ATOMIC_RELAXED, __HIP_MEMORY_SCOPE_AGENT); }
__device__ __forceinline__ unsigned xb_xcc_id() { return (unsigned)__builtin_amdgcn_s_getreg((3 << 11) | 20) & 0xFu; }
#define XB_SPIN(cond, bar) do { unsigned _sp = 0; while (cond) { __builtin_amdgcn_s_sleep(1); \
    if ((++_sp & 255u) == 0u) { if (xb_ld(&(bar)[XB_TMO])) break; if (_sp > XB_SPIN_CAP) { atomicAdd(&(bar)[XB_TMO], 1u); break; } } } } while (0)

struct XcdBarrier {
    unsigned* bar; unsigned x;
    volatile LAS unsigned* st;
};

__device__ __forceinline__ XcdBarrier xcd_barrier_post(unsigned* bar, volatile LAS unsigned* st) {
    XcdBarrier b; b.bar = bar; b.x = xb_xcc_id(); b.st = st;
    if (threadIdx.x == 0) (void)xb_add(&bar[XB_XCNT(b.x)], 1u);
    return b;
}
__device__ __forceinline__ void xcd_barrier_complete(unsigned* bar, unsigned x, unsigned& nloc, unsigned& nx) {
    const unsigned G = gridDim.x * gridDim.y * gridDim.z;
    unsigned sum, cnt, mine, sp = 0u;
    for (;;) {
        sum = 0u; cnt = 0u; mine = 0u;
#pragma unroll
        for (unsigned j = 0; j < 16; ++j) { const unsigned c = xb_ld(&bar[XB_XCNT(j)]); sum += c; cnt += (c > 0u) ? 1u : 0u; mine = (j == x) ? c : mine; }
        if (sum == G) break;
        __builtin_amdgcn_s_sleep(1);
        if ((++sp & 255u) == 0u) { if (xb_ld(&bar[XB_TMO])) break; if (sp > XB_SPIN_CAP) { atomicAdd(&bar[XB_TMO], 1u); break; } }
    }
    nloc = mine > 0u ? mine : 1u; nx = cnt > 0u ? cnt : 1u;
}

__device__ __forceinline__ void xcd_barrier(const XcdBarrier& b) {
    asm volatile("s_waitcnt vmcnt(0)" ::: "memory");
    __syncthreads();
    if (threadIdx.x == 0) {
        unsigned* bar = b.bar;
        __builtin_amdgcn_s_waitcnt(0);
        unsigned nloc = b.st[0], nx = b.st[1];
        if (nloc == 0u) { xcd_barrier_complete(bar, b.x, nloc, nx); b.st[0] = nloc; b.st[1] = nx; }
        const unsigned old = xb_add(&bar[XB_XSUB(b.x)], 1u);
        const unsigned gen = old / nloc;
        if (old + 1u == (gen + 1u) * nloc) {
            __builtin_amdgcn_fence(__ATOMIC_RELEASE, "agent");
            asm volatile("s_waitcnt vmcnt(0)" ::: "memory");
            const unsigned og = xb_add(&bar[XB_TOP], 1u);
            const unsigned tg = og / nx;
            if (og + 1u == (tg + 1u) * nx) xb_add(&bar[XB_TOPGEN], 1u);
            else XB_SPIN(xb_ld(&bar[XB_TOPGEN]) == tg, bar);
            __builtin_amdgcn_fence(__ATOMIC_ACQUIRE, "agent");
            xb_add(&bar[XB_XGEN(b.x)], 1u);
            asm volatile("s_waitcnt vmcnt(0)" ::: "memory");
        } else {
            XB_SPIN(xb_ld(&bar[XB_XGEN(b.x)]) == gen, bar);
            __builtin_amdgcn_fence(__ATOMIC_ACQUIRE, "agent");
            asm volatile("s_waitcnt vmcnt(0)" ::: "memory");
        }
    }
    __syncthreads();
}


__device__ __forceinline__ void phase_prep(const Params& p, LAS unsigned char* lds) {
    const int tid = ltid();
    bf16_t* wt = (bf16_t*)(lws(p) + WS_WT); bf16_t* ada = (bf16_t*)(lws(p) + WS_ADA);
    LAS float* tile = (LAS float*)lds;
    auto decode = [&](int id, const float*& srcp, size_t& sstride, bf16_t*& dstp) {
        const int l = id / 7488; int r = id % 7488;
        const float* src; bf16_t* dst; int K, Nsrc, map, kt, nt;
        if (r < 2304) { src = p.in[8] + (size_t)l * 1024 * 9216; Nsrc = 9216; dst = ada + (size_t)l * 9216 * 1024; K = 1024; map = 0; kt = r & 15; nt = r >> 4; }
        else if (r < 3712) { r -= 2304; src = p.in[11] + (size_t)l * 1024 * 5632; Nsrc = 5632; dst = wt + l * LW_EL + W_GU1; K = 1024; map = 1; kt = r & 15; nt = r >> 4; }
        else if (r < 4416) { r -= 3712; src = p.in[12] + (size_t)l * 2816 * 1024; Nsrc = 1024; dst = wt + l * LW_EL + W_DN1; K = 2816; map = 0; kt = r % 44; nt = r / 44; }
        else if (r < 5120) { r -= 4416; src = p.in[14] + (size_t)l * 1024 * 2824; Nsrc = 2824; dst = wt + l * LW_EL + W_IN; K = 1024; map = 2; kt = r & 15; nt = r >> 4; }
        else if (r < 5376) { r -= 5120; src = p.in[22] + (size_t)l * 1024 * 1024; Nsrc = 1024; dst = wt + l * LW_EL + W_OUT; K = 1024; map = 0; kt = r & 15; nt = r >> 4; }
        else if (r < 6784) { r -= 5376; src = p.in[24] + (size_t)l * 1024 * 5632; Nsrc = 5632; dst = wt + l * LW_EL + W_GU2; K = 1024; map = 1; kt = r & 15; nt = r >> 4; }
        else { r -= 6784; src = p.in[25] + (size_t)l * 2816 * 1024; Nsrc = 1024; dst = wt + l * LW_EL + W_DN2; K = 2816; map = 0; kt = r % 44; nt = r / 44; }
        const int k0 = kt * 64, n0 = nt * 64;
        const int n = tid & 63, kk = tid >> 6, nn = n0 + n;
        const int sc = map == 0 ? nn : (map == 1 ? (((nn & 255) >> 7) * 2816 + (nn >> 8) * 128 + (nn & 127)) : (nn < 2048 ? nn : nn + 8));
        srcp = src + (size_t)(k0 + kk) * Nsrc + sc; sstride = (size_t)8 * Nsrc;
        dstp = dst + (size_t)(n0 + (tid >> 3)) * K + k0 + 8 * (tid & 7);
    };
    float vcur[8], vnext[8], vnext2[8];
    const float* srcp; size_t sstride; bf16_t* dstp = nullptr; bf16_t* dstn = nullptr; bf16_t* dstn2 = nullptr;
    const int NT = 2 * 7488, GS = gridDim.x;
    int id = lbid();
    if (id < NT) { decode(id, srcp, sstride, dstp);
#pragma unroll
        for (int i = 0; i < 8; ++i) vcur[i] = srcp[i * sstride]; }
    if (id + GS < NT) { decode(id + GS, srcp, sstride, dstn);
#pragma unroll
        for (int i = 0; i < 8; ++i) vnext[i] = srcp[i * sstride]; }
    for (; id < NT; id += GS) {
        const int idn = id + 2 * GS;
        if (idn < NT) { decode(idn, srcp, sstride, dstn2);
#pragma unroll
            for (int i = 0; i < 8; ++i) vnext2[i] = srcp[i * sstride]; }
        {
            const int n = tid & 63, kk = tid >> 6;
#pragma unroll
            for (int i = 0; i < 8; ++i) tile[(kk + 8 * i) * 65 + n] = vcur[i];
        }
        LDS_BARRIER();
        {
            const int nn = tid >> 3, k8 = tid & 7;
            float v[8];
#pragma unroll
            for (int j = 0; j < 8; ++j) v[j] = tile[(8 * k8 + j) * 65 + nn];
            u32x4 w = {pk2(v[0], v[1]), pk2(v[2], v[3]), pk2(v[4], v[5]), pk2(v[6], v[7])};
            *(u32x4*)dstp = w;
        }
        LDS_BARRIER();
#pragma unroll
        for (int i = 0; i < 8; ++i) { vcur[i] = vnext[i]; vnext[i] = vnext2[i]; }
        dstp = dstn; dstn = dstn2;
    }
    bf16_t* sc = (bf16_t*)(lws(p) + WS_SC);
    for (int idx = lbid() * 512 + tid; idx < 256 * 1024; idx += gridDim.x * 512) {
        const int row = idx >> 10, col = idx & 1023; float v = 0.f;
        if (row < 8) v = silu_f(p.in[2][row * 1024 + col]); else if (row < NMB) v = silu_f(p.in[3][(row - 8) * 1024 + col]);
        sc[idx] = f2bf(v);
    }
    unsigned* hp = (unsigned*)(lws(p) + WS_H + (size_t)MTOT * 2048);
    for (int idx = lbid() * 512 + tid; idx < 65536; idx += gridDim.x * 512) hp[idx] = 0u;
}

__device__ __forceinline__ void phase_norm(const Params& p, LAS unsigned char* lds, int l, int which, const float* xp, const float* xs, float* xcopy) {
    const int tid = ltid(), wid = tid >> 6, lane = tid & 63;
    const float* gv = p.in[which == 0 ? 10 : (which == 1 ? 13 : 23)] + l * 1024;
    const float* mod = (const float*)(lws(p) + WS_MOD);
    bf16_t* H = (bf16_t*)(lws(p) + WS_H);
    float* pab = (float*)(lws(p) + WS_PAB);
    LAS float* wab = (LAS float*)lds;
    __syncthreads();
    if (which == 1) {
        const float* win = p.in[14] + (size_t)l * 1024 * 2824 + 2048;
        for (int i = tid; i < 2048; i += 512) { const int k = i >> 1, hf = i & 1; f32x4 v = *(const f32x4*)(win + (size_t)k * 2824 + 4 * hf); *(LAS f32x4*)(wab + k * 8 + 4 * hf) = v; }
    }
    __syncthreads();
    f32x4 g4[4];
#pragma unroll
    for (int i = 0; i < 4; ++i) g4[i] = *(const f32x4*)(gv + 256 * i + 4 * lane);
    auto do_row = [&](int r, const f32x4 (&x)[4], const f32x4 (&gs)[4], const f32x4 (&sh)[4]) {
        float ss = 0.f;
        if (xcopy != nullptr && r >= MPR) {
#pragma unroll
            for (int i = 0; i < 4; ++i) *(f32x4*)(xcopy + (size_t)r * 1024 + 256 * i + 4 * lane) = x[i];
        }
#pragma unroll
        for (int i = 0; i < 4; ++i) ss += x[i][0] * x[i][0] + x[i][1] * x[i][1] + x[i][2] * x[i][2] + x[i][3] * x[i][3];
        ss = wave_sum(ss);
        const float rstd = rsqrtf(ss * (1.0f / 1024.0f) + 1e-6f);
        float a0 = 0.f, a1 = 0.f, a2 = 0.f, a3 = 0.f, a4 = 0.f, a5 = 0.f, a6 = 0.f, a7 = 0.f;
#pragma unroll
        for (int i = 0; i < 4; ++i) {
            f32x4 h;
#pragma unroll
            for (int e = 0; e < 4; ++e) h[e] = x[i][e] * rstd * gs[i][e] + sh[i][e];
            u32x2 w = {pk2(h[0], h[1]), pk2(h[2], h[3])};
            *(u32x2*)(H + (size_t)r * 1024 + 256 * i + 4 * lane) = w;
            if (which == 1) {
#pragma unroll
                for (int e = 0; e < 4; ++e) {
                    const int k = 256 * i + 4 * lane + e;
                    const f32x4 w0 = *(const LAS f32x4*)(wab + k * 8), w1 = *(const LAS f32x4*)(wab + k * 8 + 4);
                    a0 += h[e] * w0[0]; a1 += h[e] * w0[1]; a2 += h[e] * w0[2]; a3 += h[e] * w0[3];
                    a4 += h[e] * w1[0]; a5 += h[e] * w1[1]; a6 += h[e] * w1[2]; a7 += h[e] * w1[3];
                }
            }
        }
        if (which == 1) {
            a0 = wave_sum(a0); a1 = wave_sum(a1); a2 = wave_sum(a2); a3 = wave_sum(a3); a4 = wave_sum(a4); a5 = wave_sum(a5); a6 = wave_sum(a6); a7 = wave_sum(a7);
            if (lane == 0) { f32x4 o0 = {a0, a1, a2, a3}, o1 = {a4, a5, a6, a7}; *(f32x4*)(pab + (size_t)r * 8) = o0; *(f32x4*)(pab + (size_t)r * 8 + 4) = o1; }
        }
    };
    auto load_mod = [&](int mb, f32x4 (&gs)[4], f32x4 (&sh)[4]) {
        const float* mrow = mod + (size_t)mb * MODW + l * 9216 + (3 * which) * 1024;
#pragma unroll
        for (int i = 0; i < 4; ++i) { sh[i] = *(const f32x4*)(mrow + 256 * i + 4 * lane); const f32x4 scl = *(const f32x4*)(mrow + 1024 + 256 * i + 4 * lane); gs[i] = g4[i] * (1.0f + scl); }
    };
    const int nwv = gridDim.x * 8, wg = lbid() * 8 + wid;
    for (int ck = wg; ck < MPR / 16; ck += nwv) {
        const int r0 = ck * 16;
        f32x4 gs[4], sh[4]; load_mod(r0 >> 12, gs, sh);
        const float* xb = xp + (size_t)r0 * 1024 + 4 * lane;
        f32x4 xa[4], xbuf[4], xc[4];
#pragma unroll
        for (int i = 0; i < 4; ++i) { xa[i] = *(const f32x4*)(xb + 256 * i); xbuf[i] = *(const f32x4*)(xb + 1024 + 256 * i); }
#pragma unroll 1
        for (int k = 0; k < 16; k += 2) {
            if (k + 2 < 16) {
#pragma unroll
                for (int i = 0; i < 4; ++i) xc[i] = *(const f32x4*)(xb + (size_t)(k + 2) * 1024 + 256 * i);
            }
            do_row(r0 + k, xa, gs, sh);
            if (k + 3 < 16) {
#pragma unroll
                for (int i = 0; i < 4; ++i) xa[i] = *(const f32x4*)(xb + (size_t)(k + 3) * 1024 + 256 * i);
            }
            do_row(r0 + k + 1, xbuf, gs, sh);
#pragma unroll
            for (int i = 0; i < 4; ++i) { xbuf[i] = xa[i]; xa[i] = xc[i]; }
        }
    }
    for (int sr = wg; sr < MTOT - MPR; sr += nwv) {
        const int r = MPR + sr;
        f32x4 gs[4], sh[4], x[4]; load_mod(8 + sr, gs, sh);
#pragma unroll
        for (int i = 0; i < 4; ++i) x[i] = *(const f32x4*)(xs + (size_t)sr * 1024 + 256 * i + 4 * lane);
        do_row(r, x, gs, sh);
    }
}

struct EpiAny {
    static constexpr bool PERM = true, AFTER_DRAIN = false;
    int kind; bf16_t* O; const float* xp; const float* xs; float* X; const float* gate; float s;
    __device__ __forceinline__ void operator()(const f32x4 (&acc)[2][2][4][2], const pg8::Unit& u, int wr, int wc, int fr, int fq) const {
        const int row0 = u.pm * 256 + wr * 64 + fr;
        if (kind == 0) {
            const int col0 = u.pn * 128 + wc * 32 + 8 * fq;
#pragma unroll
            for (int ai = 0; ai < 2; ++ai)
#pragma unroll
                for (int m = 0; m < 4; ++m) {
                    bf16_t* rowp = O + (size_t)(row0 + ai * 128 + m * 16) * 2816 + col0;
                    f32x4 v0, v1;
#pragma unroll
                    for (int e = 0; e < 4; ++e) { v0[e] = silu_f(acc[ai][0][m][0][e]) * acc[ai][1][m][0][e]; v1[e] = silu_f(acc[ai][0][m][1][e]) * acc[ai][1][m][1][e]; }
                    u32x4 w = {pk2(v0[0], v0[1]), pk2(v0[2], v0[3]), pk2(v1[0], v1[1]), pk2(v1[2], v1[3])};
                    *(u32x4*)rowp = w;
                }
        } else if (kind == 2) {
            const int col0 = u.pn * 256 + wc * 32 + 8 * fq;
#pragma unroll
            for (int ai = 0; ai < 2; ++ai)
#pragma unroll
                for (int m = 0; m < 4; ++m)
#pragma unroll
                    for (int bj = 0; bj < 2; ++bj) {
                        const f32x4 v0 = acc[ai][bj][m][0], v1 = acc[ai][bj][m][1];
                        u32x4 w = {pk2(v0[0], v0[1]), pk2(v0[2], v0[3]), pk2(v1[0], v1[1]), pk2(v1[2], v1[3])};
                        *(u32x4*)(O + (size_t)(row0 + ai * 128 + m * 16) * PW + col0 + bj * 128) = w;
                    }
        } else if (kind == 1) {
            const int col0 = u.pn * 256 + wc * 32 + 8 * fq;
            const float* gr = gate + (size_t)((u.pm * 256) >> 12) * MODW + col0;
            f32x4 gv[2][2];
#pragma unroll
            for (int bj = 0; bj < 2; ++bj)
#pragma unroll
                for (int n = 0; n < 2; ++n) gv[bj][n] = *(const f32x4*)(gr + bj * 128 + n * 4) * s;
#pragma unroll
            for (int ai = 0; ai < 2; ++ai)
#pragma unroll
                for (int mp = 0; mp < 2; ++mp) {
                    f32x4 xv[2][2][2];
#pragma unroll
                    for (int mm = 0; mm < 2; ++mm) {
                        const float* xr = xp + (size_t)(row0 + ai * 128 + (2 * mp + mm) * 16) * 1024 + col0;
#pragma unroll
                        for (int bj = 0; bj < 2; ++bj)
#pragma unroll
                            for (int n = 0; n < 2; ++n) xv[mm][bj][n] = *(const f32x4*)(xr + bj * 128 + n * 4);
                    }
#pragma unroll
                    for (int mm = 0; mm < 2; ++mm) {
                        float* o = X + (size_t)(row0 + ai * 128 + (2 * mp + mm) * 16) * 1024 + col0;
#pragma unroll
                        for (int bj = 0; bj < 2; ++bj)
#pragma unroll
                            for (int n = 0; n < 2; ++n) *(f32x4*)(o + bj * 128 + n * 4) = xv[mm][bj][n] + gv[bj][n] * acc[ai][bj][2 * mp + mm][n];
                    }
                }
        } else {
            const int col0 = u.pn * 256 + wc * 32 + 8 * fq;
            f32x4 gv[2][2];
#pragma unroll
            for (int bj = 0; bj < 2; ++bj)
#pragma unroll
                for (int n = 0; n < 2; ++n) gv[bj][n] = *(const f32x4*)(gate + col0 + bj * 128 + n * 4);
#pragma unroll
            for (int ai = 0; ai < 2; ++ai)
#pragma unroll
                for (int m = 0; m < 4; ++m) {
                    const int row = row0 + ai * 128 + m * 16;
                    if (row < NMB) {
                        float* o = X + (size_t)row * MODW + col0;
#pragma unroll
                        for (int bj = 0; bj < 2; ++bj)
#pragma unroll
                            for (int n = 0; n < 2; ++n) *(f32x4*)(o + bj * 128 + n * 4) = acc[ai][bj][m][n] + gv[bj][n];
                    }
                }
        }
    }
};
template <class Epi> __device__ __forceinline__ void run_gemm(LAS unsigned char* lds, const bf16_t* A, const bf16_t* Bt, int Mg, int N, int K, const Epi& E) {
    pg8::Gemm g{A, Bt, Mg, N, K}; pg8::StaticOrder S; S.init(Mg, N, (int)gridDim.x, lbid());
    __syncthreads();
    pg8::gemm_phase<Epi, pg8::StaticOrder, false>(lds, g, S, E, nullptr);
    __syncthreads();
}

__device__ __forceinline__ void skinny_gemm(const EpiAny& E, const bf16_t* A, const bf16_t* Bt, int N, int K) {
    const int tid = ltid(), wid = tid >> 6, lane = tid & 63, fr = lane & 15, fq = lane >> 4;
    const int G = gridDim.x, nunits = E.kind == 1 ? (N / 16) * 4 : (E.kind == 0 ? N / 2 : N) / 16;
    const bf16_t* arow = A + (size_t)(MPR + 16 * wid + fr) * K + 8 * fq;
    for (int u = G - 1 - lbid(); u < nunits; u += G) {
        const int j0 = E.kind == 1 ? 16 * (u >> 2) : 16 * u;
        const int kbeg = E.kind == 1 ? (u & 3) * (K >> 2) : 0, kend = E.kind == 1 ? kbeg + (K >> 2) : K;
        const bf16_t* b0; const bf16_t* b1;
        if (E.kind == 0) { const int T = j0 >> 7, off = j0 & 127; b0 = Bt + (size_t)(256 * T + off + fr) * K + 8 * fq; b1 = b0 + (size_t)128 * K; }
        else { b0 = Bt + (size_t)(j0 + fr) * K + 8 * fq; b1 = b0; }
        f32x4 acc0 = {0.f, 0.f, 0.f, 0.f}, acc1 = {0.f, 0.f, 0.f, 0.f};
        if (E.kind == 0) {
#pragma unroll 16
            for (int k = 0; k < K; k += 32) {
                const bf16x8 af = *(const bf16x8*)(arow + k), bf0 = *(const bf16x8*)(b0 + k), bf1 = *(const bf16x8*)(b1 + k);
                acc0 = MFMA16(bf0, af, acc0); acc1 = MFMA16(bf1, af, acc1);
            }
        } else {
#pragma unroll 8
            for (int k = kbeg; k < kend; k += 32) {
                const bf16x8 af = *(const bf16x8*)(arow + k), bf0 = *(const bf16x8*)(b0 + k);
                acc0 = MFMA16(bf0, af, acc0);
            }
        }
        const int row = MPR + 16 * wid + fr, c = j0 + 4 * fq;
        if (E.kind == 0) {
            f32x4 v;
#pragma unroll
            for (int e = 0; e < 4; ++e) v[e] = silu_f(acc0[e]) * acc1[e];
            u32x2 w = {pk2(v[0], v[1]), pk2(v[2], v[3])};
            *(u32x2*)(E.O + (size_t)row * 2816 + c) = w;
        } else if (E.kind == 2) {
            u32x2 w = {pk2(acc0[0], acc0[1]), pk2(acc0[2], acc0[3])};
            *(u32x2*)(E.O + (size_t)row * PW + c) = w;
        } else {
            const float* gr = E.gate + (size_t)(8 + row - MPR) * MODW;
            const f32x4 gv = *(const f32x4*)(gr + c); float* o = E.X + (size_t)row * 1024 + c;
#pragma unroll
            for (int e = 0; e < 4; ++e) unsafeAtomicAdd(o + e, E.s * gv[e] * acc0[e]);
        }
    }
}

__device__ __forceinline__ void sample_dn(const Params& p, LAS unsigned char* lds, int l, int item) {
    const int tid = ltid(), wid = tid >> 6, lane = tid & 63;
    const int b = item >> 2, h = item & 3; const size_t r = (size_t)MPR + b;
    const bf16_t* P = (const bf16_t*)(lws(p) + WS_HID); bf16_t* MIX = (bf16_t*)(lws(p) + WS_H);
    const float* pab = (const float*)(lws(p) + WS_PAB);
    LAS float* yq = (LAS float*)lds; LAS float* yk = yq + 128; LAS float* yv = yk + 128; LAS float* red = yv + 128; LAS float* pk_ = red + 16; LAS float* pq_ = pk_ + 512;
    LDS_BARRIER();
    if (tid < 384) {
        const int sel = tid >> 7, d = tid & 127, cc = sel * 512 + h * 128 + d;
        const float x = bf2f(P[r * PW + cc]);
        const float* sb = p.in[4] + ((size_t)(l * 128 + b) * 3) * 1536 + cc;
        const float b0 = sb[0], b1 = sb[1536], b2 = sb[3072];
        const float* cw = p.in[15] + (size_t)l * 4 * 1536 + cc;
        const float y = cw[0] * b0 + cw[1536] * b1 + cw[3072] * b2 + cw[4608] * x;
        float* co = lout(p) + O_CVS + ((size_t)(l * 128 + b) * 3) * 1536 + cc;
        co[0] = b1; co[1536] = b2; co[3072] = x;
        yq[sel * 128 + d] = silu_f(y);
    }
    LDS_BARRIER();
    if (wid < 2) { const float a = yq[wid * 128 + lane], c2 = yq[wid * 128 + 64 + lane]; const float s = wave_sum(a * a + c2 * c2); if (lane == 0) red[wid] = s; }
    LDS_BARRIER();
    const float rq = rsqrtf(red[0] + 1e-6f) * 0.08838834764831845f, rk = rsqrtf(red[1] + 1e-6f);
    const float pb = pab[r * 8 + h], pa = pab[r * 8 + 4 + h];
    const float beta = 1.0f / (1.0f + expf(-pb));
    const float xx = pa + p.in[17][l * 4 + h];
    const float g = -expf(p.in[16][l * 4 + h]) * (fmaxf(xx, 0.f) + log1pf(expf(-fabsf(xx))));
    const float eg = expf(g);
    const int e = tid & 127, dq = tid >> 7;
    const float* S0 = p.in[5] + ((size_t)(l * 128 + b) * 4 + h) * 16384;
    float s[32]; float ak = 0.f, aq = 0.f;
#pragma unroll
    for (int i = 0; i < 32; ++i) { const int d = 32 * dq + i; s[i] = S0[d * 128 + e]; ak += yk[d] * rk * s[i]; aq += yq[d] * rq * s[i]; }
    pk_[dq * 128 + e] = ak; pq_[dq * 128 + e] = aq;
    const float qk = wave_sum(yq[lane] * yk[lane] + yq[64 + lane] * yk[64 + lane]) * rq * rk;
    LDS_BARRIER();
    const float kS = pk_[e] + pk_[128 + e] + pk_[256 + e] + pk_[384 + e], qS = pq_[e] + pq_[128 + e] + pq_[256 + e] + pq_[384 + e];
    const float vnew = beta * (yv[e] - eg * kS), o = eg * qS + qk * vnew;
    float* So = lout(p) + O_SS + ((size_t)(l * 128 + b) * 4 + h) * 16384;
#pragma unroll
    for (int i = 0; i < 32; ++i) { const int d = 32 * dq + i; So[d * 128 + e] = eg * s[i] + yk[d] * rk * vnew; }
    if (tid < 128) { const float ss = wave_sum(o * o); if (lane == 0) red[4 + wid] = ss; }
    LDS_BARRIER();
    if (tid < 128) {
        const float rstd = rsqrtf((red[4] + red[5]) * (1.0f / 128.0f) + 1e-6f);
        const float z = bf2f(P[r * PW + ZC + h * 128 + e]);
        MIX[r * 1024 + h * 128 + e] = f2bf(o * rstd * p.in[18][l * 128 + e] * silu_f(z));
    }
}

__device__ __forceinline__ void sample_swa(const Params& p, LAS unsigned char* lds, int l, int b) {
    const int tid = ltid(), wid = tid >> 6, lane = tid & 63;
    const size_t r = (size_t)MPR + b;
    const bf16_t* P = (const bf16_t*)(lws(p) + WS_HID); bf16_t* MIX = (bf16_t*)(lws(p) + WS_H);
    LAS float* qs = (LAS float*)lds; LAS float* ks = qs + 512; LAS float* vs = ks + 128; LAS float* ps = vs + 128;
    LDS_BARRIER();
    if (tid < 320) {
        const int head = tid >> 5, i = tid & 31;
        const float inv = exp2f(-(float)i * (13.287712379549449f / 32.0f));
        float rev = (16384.0f * inv) * 0.15915494309189535f; rev -= floorf(rev);
        const float sn = __builtin_amdgcn_sinf(rev), cs = __builtin_amdgcn_cosf(rev);
        const int col = (head < 8 ? SQ + head * 64 : SK + (head - 8) * 64) + i;
        const float x1 = bf2f(P[r * PW + col]), x2 = bf2f(P[r * PW + col + 32]);
        float ss = x1 * x1 + x2 * x2;
#pragma unroll
        for (int o = 1; o < 32; o <<= 1) ss += __shfl_xor(ss, o);
        const float rstd = rsqrtf(ss * (1.0f / 64.0f) + 1e-6f);
        const float* nw = p.in[head < 8 ? 19 : 20] + l * 64;
        const float y1 = x1 * rstd * nw[i], y2 = x2 * rstd * nw[i + 32];
        const float o1 = y1 * cs - y2 * sn, o2 = y2 * cs + y1 * sn;
        if (head < 8) { qs[head * 64 + i] = o1 * 0.125f; qs[head * 64 + i + 32] = o2 * 0.125f; }
        else { ks[(head - 8) * 64 + i] = o1; ks[(head - 8) * 64 + i + 32] = o2; }
    }
    if (tid >= 384) { const int c = tid - 384; vs[c] = bf2f(P[r * PW + SV + c]); }
    LDS_BARRIER();
    const float* ck = p.in[6] + (size_t)(l * 128 + b) * 16384; const float* cv = p.in[7] + (size_t)(l * 128 + b) * 16384;
    float* ko = lout(p) + O_KS + (size_t)(l * 128 + b) * 16384; float* vo = lout(p) + O_VS + (size_t)(l * 128 + b) * 16384;
    for (int idx = tid; idx < 4096; idx += 512) {
        const int j = idx >> 5, c4 = idx & 31; f32x4 kv, vv;
        if (j < 127) { kv = *(const f32x4*)(ck + (j + 1) * 128 + 4 * c4); vv = *(const f32x4*)(cv + (j + 1) * 128 + 4 * c4); }
        else { kv = *(const LAS f32x4*)(ks + 4 * c4); vv = *(const LAS f32x4*)(vs + 4 * c4); }
        *(f32x4*)(ko + j * 128 + 4 * c4) = kv; *(f32x4*)(vo + j * 128 + 4 * c4) = vv;
    }
    {
        const int h = wid, hk = h >> 2; float s0 = 0.f, s1 = 0.f, s2 = 0.f;
        const float* k0 = ck + lane * 128 + hk * 64; const float* k1 = ck + (lane + 64) * 128 + hk * 64;
#pragma unroll
        for (int c4 = 0; c4 < 16; ++c4) {
            const f32x4 q4 = *(const LAS f32x4*)(qs + h * 64 + 4 * c4), a = *(const f32x4*)(k0 + 4 * c4), bb = *(const f32x4*)(k1 + 4 * c4), kk = *(const LAS f32x4*)(ks + hk * 64 + 4 * c4);
            s0 += q4[0] * a[0] + q4[1] * a[1] + q4[2] * a[2] + q4[3] * a[3];
            s1 += q4[0] * bb[0] + q4[1] * bb[1] + q4[2] * bb[2] + q4[3] * bb[3];
            s2 += q4[0] * kk[0] + q4[1] * kk[1] + q4[2] * kk[2] + q4[3] * kk[3];
        }
        const float sink = p.in[21][l * 8 + h];
        const float m = fmaxf(fmaxf(wave_max(fmaxf(s0, s1)), s2), sink);
        const float p0 = __expf(s0 - m), p1 = __expf(s1 - m), p2 = __expf(s2 - m);
        const float sum = wave_sum(p0 + p1) + p2 + __expf(sink - m);
        ps[h * 132 + lane] = p0; ps[h * 132 + 64 + lane] = p1;
        if (lane == 0) { ps[h * 132 + 128] = p2; ps[h * 132 + 129] = 1.0f / sum; }
    }
    LDS_BARRIER();
    {
        const int h = wid, hk = h >> 2, d = lane; float o = 0.f;
        for (int j = 0; j < 128; ++j) o += ps[h * 132 + j] * cv[j * 128 + hk * 64 + d];
        o += ps[h * 132 + 128] * vs[hk * 64 + d]; o *= ps[h * 132 + 129];
        MIX[r * 1024 + 512 + h * 64 + d] = f2bf(o);
    }
}

__device__ __forceinline__ void swa_prep(const Params& p, int l) {
    const int tid = ltid(), wid = tid >> 6, lane = tid & 63, i = lane & 31;
    bf16_t* P = (bf16_t*)(lws(p) + WS_HID);
    const float inv = exp2f(-(float)i * (13.287712379549449f / 32.0f));
    const float qw1 = p.in[19][l * 64 + i], qw2 = p.in[19][l * 64 + i + 32], kw1 = p.in[20][l * 64 + i], kw2 = p.in[20][l * 64 + i + 32];
    for (int r0 = (lbid() * 8 + wid) * 2; r0 < MPR; r0 += gridDim.x * 16) {
        float x1[2][5], x2[2][5]; unsigned vv[2][2];
#pragma unroll
        for (int rr = 0; rr < 2; ++rr) {
            const bf16_t* pr = P + (size_t)(r0 + rr) * PW;
#pragma unroll
            for (int k = 0; k < 5; ++k) {
                const int head = 2 * k + (lane >> 5);
                const int col = (head < 8 ? SQ + head * 64 : SK + (head - 8) * 64) + i;
                x1[rr][k] = bf2f(pr[col]); x2[rr][k] = bf2f(pr[col + 32]);
            }
            vv[rr][0] = pr[SV + lane]; vv[rr][1] = pr[SV + 64 + lane];
        }
#pragma unroll
        for (int rr = 0; rr < 2; ++rr) {
            const int r = r0 + rr, t = r & 4095, b = r >> 12;
            float rev = ((float)t * inv) * 0.15915494309189535f; rev -= floorf(rev);
            const float sn = __builtin_amdgcn_sinf(rev), cs = __builtin_amdgcn_cosf(rev);
            bf16_t* pr = P + (size_t)r * PW;
#pragma unroll
            for (int k = 0; k < 5; ++k) {
                const int head = 2 * k + (lane >> 5);
                const int col = (head < 8 ? SQ + head * 64 : SK + (head - 8) * 64) + i;
                float ss = x1[rr][k] * x1[rr][k] + x2[rr][k] * x2[rr][k];
#pragma unroll
                for (int o = 1; o < 32; o <<= 1) ss += __shfl_xor(ss, o);
                const float rstd = rsqrtf(ss * (1.0f / 64.0f) + 1e-6f);
                const float y1 = x1[rr][k] * rstd * (head < 8 ? qw1 : kw1), y2 = x2[rr][k] * rstd * (head < 8 ? qw2 : kw2);
                float o1 = y1 * cs - y2 * sn, o2 = y2 * cs + y1 * sn;
                if (head < 8) { o1 *= 0.125f; o2 *= 0.125f; }
                pr[col] = f2bf(o1); pr[col + 32] = f2bf(o2);
                if (head >= 8 && t >= 3968) { float* ko = lout(p) + O_KP + (((size_t)l * 8 + b) * 128 + (t - 3968)) * 128 + (head - 8) * 64 + i; ko[0] = o1; ko[32] = o2; }
            }
            if (t >= 3968) { float* vo = lout(p) + O_VP + (((size_t)l * 8 + b) * 128 + (t - 3968)) * 128; vo[lane] = bf2f((unsigned short)vv[rr][0]); vo[lane + 64] = bf2f((unsigned short)vv[rr][1]); }
        }
    }
}

__device__ __forceinline__ void dn_chunk_prep(const Params& p, LAS unsigned char* lds, int l, int chid, int next_chid) {
    const int tid = ltid(), wid = tid >> 6, lane = tid & 63, fr = lane & 15, fq = lane >> 4;
    const int h = chid & 3, n = (chid >> 2) & 63, b = chid >> 8;
    const bf16_t* P = (const bf16_t*)(lws(p) + WS_HID);
    const float* pab = (const float*)(lws(p) + WS_PAB);
    bf16_t* UT = (bf16_t*)(lws(p) + WS_UT); bf16_t* Wg = (bf16_t*)(lws(p) + WS_W); bf16_t* QD = (bf16_t*)(lws(p) + WS_QD); bf16_t* KDT = (bf16_t*)(lws(p) + WS_KDT);
    bf16_t* QKM = (bf16_t*)(lws(p) + WS_QKM); float* GLE = (float*)(lws(p) + WS_GLE);
    LAS unsigned char* qn = lds; LAS unsigned char* kn = lds + 17408;
    LAS float* VB = (LAS float*)(lds + 34816); LAS float* KBG = (LAS float*)(lds + 67584); LAS float* AM = (LAS float*)(lds + 100352);
    LAS float* GC = (LAS float*)(lds + 116736); LAS float* BETA = GC + 64;
    const size_t rbase = (size_t)b * 4096 + n * 64;
    LDS_BARRIER();
    float beta_t, gc_t;
    {
        const float* pr = pab + (rbase + lane) * 8; const float pb = pr[h], pa = pr[4 + h];
        beta_t = 1.0f / (1.0f + expf(-pb));
        const float xx = pa + p.in[17][l * 4 + h];
        float v = -expf(p.in[16][l * 4 + h]) * (fmaxf(xx, 0.f) + log1pf(expf(-fabsf(xx))));
#pragma unroll
        for (int o = 1; o < 64; o <<= 1) { const float t = __shfl_up(v, o); if (lane >= o) v += t; }
        gc_t = v;
        if (wid == 0) { GC[lane] = gc_t; BETA[lane] = beta_t; }
    }
    {
        const float* cw = p.in[15] + (size_t)l * 4 * 1536 + h * 128 + 2 * lane;
        float wq[4][2], wk[4][2], wv[4][2];
#pragma unroll
        for (int j = 0; j < 4; ++j)
#pragma unroll
            for (int e = 0; e < 2; ++e) { wq[j][e] = cw[j * 1536 + e]; wk[j][e] = cw[j * 1536 + 512 + e]; wv[j][e] = cw[j * 1536 + 1024 + e]; }
        float xq[11][2], xk[11][2], xv[11][2];
#pragma unroll
        for (int j = 0; j < 11; ++j) {
            const int ts = n * 64 + 8 * wid + j - 3;
            const bf16_t* pr = P + ((size_t)b * 4096 + (ts >= 0 ? ts : 0)) * PW + h * 128 + 2 * lane;
            unsigned uq = *(const unsigned*)pr, uk = *(const unsigned*)(pr + 512), uv = *(const unsigned*)(pr + 1024);
            if (ts < 0) { uq = 0u; uk = 0u; uv = 0u; }
            xq[j][0] = lo_bf(uq); xq[j][1] = hi_bf(uq); xk[j][0] = lo_bf(uk); xk[j][1] = hi_bf(uk); xv[j][0] = lo_bf(uv); xv[j][1] = hi_bf(uv);
        }
#pragma unroll
        for (int i = 0; i < 8; ++i) {
            const int c = 8 * wid + i;
            float yq[2], yk[2], yv[2];
#pragma unroll
            for (int e = 0; e < 2; ++e) {
                yq[e] = silu_f(wq[0][e] * xq[i][e] + wq[1][e] * xq[i + 1][e] + wq[2][e] * xq[i + 2][e] + wq[3][e] * xq[i + 3][e]);
                yk[e] = silu_f(wk[0][e] * xk[i][e] + wk[1][e] * xk[i + 1][e] + wk[2][e] * xk[i + 2][e] + wk[3][e] * xk[i + 3][e]);
                yv[e] = silu_f(wv[0][e] * xv[i][e] + wv[1][e] * xv[i + 1][e] + wv[2][e] * xv[i + 2][e] + wv[3][e] * xv[i + 3][e]);
            }
            const float sq = wave_sum(yq[0] * yq[0] + yq[1] * yq[1]), sk = wave_sum(yk[0] * yk[0] + yk[1] * yk[1]);
            const float rq = rsqrtf(sq + 1e-6f) * 0.08838834764831845f, rk = rsqrtf(sk + 1e-6f);
            const float gcc = __shfl(gc_t, c), bc = __shfl(beta_t, c); const float eg = __expf(gcc);
            const float q0 = yq[0] * rq, q1 = yq[1] * rq, k0 = yk[0] * rk, k1 = yk[1] * rk;
            *(LAS unsigned*)(qn + c * 272 + 4 * lane) = pk2(q0, q1);
            *(LAS unsigned*)(kn + c * 272 + 4 * lane) = pk2(k0, k1);
            f32x2 vb = {yv[0] * bc, yv[1] * bc}, kb = {k0 * bc * eg, k1 * bc * eg};
            *(LAS f32x2*)(VB + c * 128 + 2 * lane) = vb; *(LAS f32x2*)(KBG + c * 128 + 2 * lane) = kb;
            *(unsigned*)(QD + ((size_t)chid * 64 + c) * 128 + kpos(2 * lane)) = pk2(q0 * eg, q1 * eg);
        }
    }
    LDS_BARRIER();
#pragma unroll
    for (int it = 0; it < 4; ++it) {
        const int id = wid * 4 + it, isqk = id >> 4, ti = (id >> 2) & 3, tj = id & 3;
        f32x4 acc = {0.f, 0.f, 0.f, 0.f};
        if (ti >= tj) {
            const LAS unsigned char* bsrc = isqk ? qn : kn;
#pragma unroll
            for (int s = 0; s < 4; ++s) {
                const bf16x8 a = *(const LAS bf16x8*)(kn + (16 * tj + fr) * 272 + (32 * s + 8 * fq) * 2);
                const bf16x8 bb = *(const LAS bf16x8*)(bsrc + (16 * ti + fr) * 272 + (32 * s + 8 * fq) * 2);
                acc = MFMA16(a, bb, acc);
            }
        }
        const int i = 16 * ti + fr; const float gi = GC[i], bi = BETA[i];
        f32x4 val;
#pragma unroll
        for (int jj = 0; jj < 4; ++jj) {
            const int j = 16 * tj + 4 * fq + jj;
            const float v = acc[jj] * __expf(fminf(gi - GC[j], 0.f));
            val[jj] = isqk ? ((i >= j) ? v : 0.f) : ((i > j) ? v * bi : 0.f);
        }
        if (isqk) { u32x2 w = {pk2(val[0], val[1]), pk2(val[2], val[3])}; *(u32x2*)(QKM + ((size_t)chid * 64 + i) * 64 + kpos(16 * tj + 4 * fq)) = w; }
        else *(LAS f32x4*)(AM + i * 64 + 16 * tj + 4 * fq) = val;
    }
    LDS_BARRIER();
    if (wid < 4) {
        const LAS float* mat = (wid < 2) ? VB : KBG; const int d = (wid & 1) * 64 + lane;
        f32x2 x2[32];
#pragma unroll
        for (int c = 0; c < 32; ++c) x2[c] = (f32x2){mat[(2 * c) * 128 + d], mat[(2 * c + 1) * 128 + d]};
        const LAS float* am = AM; asm volatile("" : "+v"(am));
        f32x4 abuf[2][16];
        abuf[1][0] = *(const LAS f32x4*)(am + 64);
#pragma unroll
        for (int i = 1; i < 64; ++i) {
            if (i + 1 < 64) {
#pragma unroll
                for (int j4 = 0; j4 < (i + 4) / 4; ++j4) abuf[(i + 1) & 1][j4] = *(const LAS f32x4*)(am + (i + 1) * 64 + 4 * j4);
            }
            SCHED_FENCE();
            f32x2 sA = {0.f, 0.f}, sB = {0.f, 0.f};
#pragma unroll
            for (int j4 = 0; j4 < (i + 3) / 4; ++j4) {
                const f32x4 a = abuf[i & 1][j4];
                sA = __builtin_elementwise_fma(__builtin_shufflevector(a, a, 0, 1), x2[2 * j4], sA);
                sB = __builtin_elementwise_fma(__builtin_shufflevector(a, a, 2, 3), x2[2 * j4 + 1], sB);
            }
            const f32x2 st = sA + sB;
            x2[i >> 1][i & 1] -= st[0] + st[1];
            SCHED_FENCE();
        }
        float x[64];
#pragma unroll
        for (int c = 0; c < 32; ++c) { x[2 * c] = x2[c][0]; x[2 * c + 1] = x2[c][1]; }
        if (wid < 2) {
            bf16_t* ut = UT + ((size_t)chid * 128 + d) * 64;
#pragma unroll
            for (int k = 0; k < 8; ++k) { u32x4 w = {pk2(x[8 * k], x[8 * k + 1]), pk2(x[8 * k + 2], x[8 * k + 3]), pk2(x[8 * k + 4], x[8 * k + 5]), pk2(x[8 * k + 6], x[8 * k + 7])}; *(u32x4*)(ut + 8 * k) = w; }
        } else {
            bf16_t* wp = Wg + (size_t)chid * 8192 + kpos(d);
#pragma unroll
            for (int c = 0; c < 64; ++c) wp[c * 128] = f2bf(x[c]);
        }
    } else {
        const int t2 = tid - 256, d = t2 & 127, hf = t2 >> 7; const float gl = GC[63];
        unsigned pfd = 0u;
        if (next_chid >= 0) {
            const int h2 = next_chid & 3, n2 = (next_chid >> 2) & 63, b2 = next_chid >> 8;
#pragma unroll
            for (int k2 = 0; k2 < 2; ++k2) {
                const int idx = t2 + 256 * k2;
                if (idx < 402) {
                    const int rr = idx / 6, pc = idx % 6; const int ts = n2 * 64 + rr - 3;
                    const char* ap = (const char*)(P + ((size_t)b2 * 4096 + (ts >= 0 ? ts : 0)) * PW + (pc >> 1) * 512 + h2 * 128) + (pc & 1) * 128;
                    asm volatile("global_load_dword %0, %1, off" : "+v"(pfd) : "v"(ap) : "memory");
                }
            }
            if (t2 < 16) { const char* ap = (const char*)(pab + ((size_t)b2 * 4096 + n2 * 64) * 8) + t2 * 128; asm volatile("global_load_dword %0, %1, off" : "+v"(pfd) : "v"(ap) : "memory"); }
        }
#pragma unroll
        for (int c8 = 0; c8 < 4; ++c8) {
            float v[8];
#pragma unroll
            for (int e = 0; e < 8; ++e) { const int c = 32 * hf + 8 * c8 + e; v[e] = bf2f(*(const LAS bf16_t*)(kn + c * 272 + 2 * d)) * __expf(gl - GC[c]); }
            u32x2 w0 = {pk2(v[0], v[1]), pk2(v[2], v[3])}, w1 = {pk2(v[4], v[5]), pk2(v[6], v[7])};
            bf16_t* kdrow = KDT + ((size_t)chid * 128 + d) * 64;
            *(u32x2*)(kdrow + kpos(32 * hf + 8 * c8)) = w0; *(u32x2*)(kdrow + kpos(32 * hf + 8 * c8 + 4)) = w1;
        }
        if (t2 == 0) GLE[chid] = expf(gl);
        asm volatile("s_waitcnt vmcnt(0)" ::: "memory");
        asm volatile("" :: "v"(pfd));
    }
}

constexpr int SCAN_CW = 4, SCAN_BPC = 2, SCAN_NBLK = 64;
constexpr int SC_OFF_W = 0, SC_OFF_QD = 17408, SC_OFF_KDT = 34816, SC_OFF_QK = 53248, SC_OFF_U = 62464, SC_BUFSZ = 71680;
__device__ __forceinline__ bf16x8 rd16(const LAS unsigned char* p) { return *(const LAS bf16x8*)p; }
__device__ __forceinline__ void dn_scan_step(const LAS unsigned char* base, f32x4 (&S)[8], const LAS unsigned char* urow, float gle, bf16_t* orow, int fr, int fq) {
    bf16x8 sf[4];
#pragma unroll
    for (int s = 0; s < 4; ++s) sf[s] = pack_frag(S[2 * s], S[2 * s + 1]);
    bf16x8 wq[2][8], kf[4][2];
    u32x2 uc[4];
#pragma unroll
    for (int t = 0; t < 4; ++t) uc[t] = *(const LAS u32x2*)(urow + 32 * t);
    f32x4 vn[4], oT[4];
#pragma unroll
    for (int s = 0; s < 4; ++s) { wq[0][s] = rd16(base + SC_OFF_W + fr * 272 + 64 * s + 16 * fq); wq[0][4 + s] = rd16(base + SC_OFF_QD + fr * 272 + 64 * s + 16 * fq); }
#pragma unroll
    for (int t = 0; t < 4; ++t) {
        if (t < 3) {
#pragma unroll
            for (int s = 0; s < 4; ++s) { wq[(t + 1) & 1][s] = rd16(base + SC_OFF_W + (16 * (t + 1) + fr) * 272 + 64 * s + 16 * fq); wq[(t + 1) & 1][4 + s] = rd16(base + SC_OFF_QD + (16 * (t + 1) + fr) * 272 + 64 * s + 16 * fq); }
        } else {
#pragma unroll
            for (int tt = 0; tt < 4; ++tt)
#pragma unroll
                for (int s = 0; s < 2; ++s) kf[tt][s] = rd16(base + SC_OFF_QK + (16 * tt + fr) * 144 + 64 * s + 16 * fq);
        }
        SCHED_FENCE();
        f32x4 a1 = {0.f, 0.f, 0.f, 0.f}, a2 = {0.f, 0.f, 0.f, 0.f};
#pragma unroll
        for (int s = 0; s < 4; ++s) { a1 = MFMA16(wq[t & 1][s], sf[s], a1); a2 = MFMA16(sf[s], wq[t & 1][4 + s], a2); }
        vn[t] = (f32x4){lo_bf(uc[t][0]) - a1[0], hi_bf(uc[t][0]) - a1[1], lo_bf(uc[t][1]) - a1[2], hi_bf(uc[t][1]) - a1[3]}; oT[t] = a2;
        SCHED_FENCE();
    }
    bf16x8 vf[2]; vf[0] = pack_frag(vn[0], vn[1]); vf[1] = pack_frag(vn[2], vn[3]);
    bf16x8 kda[4][2], kdb[4][2];
#pragma unroll
    for (int t = 0; t < 4; ++t)
#pragma unroll
        for (int s = 0; s < 2; ++s) kda[t][s] = rd16(base + SC_OFF_KDT + (16 * t + fr) * 144 + 64 * s + 16 * fq);
    SCHED_FENCE();
#pragma unroll
    for (int t = 0; t < 4; ++t) {
#pragma unroll
        for (int s = 0; s < 2; ++s) oT[t] = MFMA16(vf[s], kf[t][s], oT[t]);
    }
#pragma unroll
    for (int t = 0; t < 4; ++t)
#pragma unroll
        for (int s = 0; s < 2; ++s) kdb[t][s] = rd16(base + SC_OFF_KDT + (16 * (t + 4) + fr) * 144 + 64 * s + 16 * fq);
    SCHED_FENCE();
#pragma unroll
    for (int t = 0; t < 4; ++t) {
        f32x4 a = S[t] * gle;
#pragma unroll
        for (int s = 0; s < 2; ++s) a = MFMA16(kda[t][s], vf[s], a);
        S[t] = a;
    }
#pragma unroll
    for (int t = 0; t < 4; ++t) { u32x2 w_ = {pk2(oT[t][0], oT[t][1]), pk2(oT[t][2], oT[t][3])}; *(u32x2*)(orow + (size_t)(16 * t) * 1024) = w_; }
    SCHED_FENCE();
#pragma unroll
    for (int t = 0; t < 4; ++t) {
        f32x4 a = S[4 + t] * gle;
#pragma unroll
        for (int s = 0; s < 2; ++s) a = MFMA16(kdb[t][s], vf[s], a);
        S[4 + t] = a;
    }
}
__device__ __forceinline__ void dn_scan(const Params& p, LAS unsigned char* lds, int l, int item) {
    const int tid = ltid(), wid = tid >> 6, lane = tid & 63, fr = lane & 15, fq = lane >> 4;
    const int chain = (item >> 4) * 8 + (item & 7), part = (item >> 3) & 1;
    const int b = chain >> 2, h = chain & 3, n0 = 16 * (part * 4 + (wid & 3));
    const bool cw = wid < 4;
    const bf16_t* UT = (const bf16_t*)(lws(p) + WS_UT); const bf16_t* Wg = (const bf16_t*)(lws(p) + WS_W); const bf16_t* QD = (const bf16_t*)(lws(p) + WS_QD);
    const bf16_t* KDT = (const bf16_t*)(lws(p) + WS_KDT); const bf16_t* QKM = (const bf16_t*)(lws(p) + WS_QKM); const float* GLE = (const float*)(lws(p) + WS_GLE);
    bf16_t* MIX = (bf16_t*)(lws(p) + WS_H);
    const int lt = tid - 256;
    const float gle_all = GLE[(b * 64 + lane) * 4 + h];
#define DN_LOAD(st, nn) do { const size_t ch_ = (size_t)((b * 64 + (nn)) * 4 + h); \
        const u32x4* g0_ = (const u32x4*)(Wg + ch_ * 8192); const u32x4* g1_ = (const u32x4*)(QD + ch_ * 8192); const u32x4* g2_ = (const u32x4*)(KDT + ch_ * 8192); const u32x4* g3_ = (const u32x4*)(QKM + ch_ * 4096); \
        const u32x4* g4_ = (const u32x4*)(UT + (ch_ * 128 + part * 64) * 64); \
        _Pragma("unroll") for (int k_ = 0; k_ < 6; ++k_) { const int c_ = lt + 192 * k_; if (k_ < 5 || lt < 64) { st[k_] = g0_[c_]; st[6 + k_] = g1_[c_]; st[12 + k_] = g2_[c_]; } } \
        _Pragma("unroll") for (int k_ = 0; k_ < 3; ++k_) { const int c_ = lt + 192 * k_; if (k_ < 2 || lt < 128) { st[18 + k_] = g3_[c_]; st[21 + k_] = g4_[c_]; } } } while (0)
#define DN_WRITE(st, buf) do { LAS unsigned char* bb_ = lds + (buf) * SC_BUFSZ; \
        _Pragma("unroll") for (int k_ = 0; k_ < 6; ++k_) { const int c_ = lt + 192 * k_; if (k_ < 5 || lt < 64) { \
            *(LAS u32x4*)(bb_ + SC_OFF_W + (c_ >> 4) * 272 + (c_ & 15) * 16) = st[k_]; *(LAS u32x4*)(bb_ + SC_OFF_QD + (c_ >> 4) * 272 + (c_ & 15) * 16) = st[6 + k_]; \
            *(LAS u32x4*)(bb_ + SC_OFF_KDT + (c_ >> 3) * 144 + (c_ & 7) * 16) = st[12 + k_]; } } \
        _Pragma("unroll") for (int k_ = 0; k_ < 3; ++k_) { const int c_ = lt + 192 * k_; if (k_ < 2 || lt < 128) { \
            *(LAS u32x4*)(bb_ + SC_OFF_QK + (c_ >> 3) * 144 + (c_ & 7) * 16) = st[18 + k_]; *(LAS u32x4*)(bb_ + SC_OFF_U + (c_ >> 3) * 144 + (c_ & 7) * 16) = st[21 + k_]; } } } while (0)
#define DN_TOUCH(nn) do { const size_t ch_ = (size_t)((b * 64 + (nn)) * 4 + h); \
        _Pragma("unroll") for (int k_ = 0; k_ < 2; ++k_) { \
            asm volatile("global_load_dword %0, %1, off" : "+v"(pfd) : "v"((const char*)(Wg + ch_ * 8192) + (lane + 64 * k_) * 128) : "memory"); \
            asm volatile("global_load_dword %0, %1, off" : "+v"(pfd) : "v"((const char*)(QD + ch_ * 8192) + (lane + 64 * k_) * 128) : "memory"); \
            asm volatile("global_load_dword %0, %1, off" : "+v"(pfd) : "v"((const char*)(KDT + ch_ * 8192) + (lane + 64 * k_) * 128) : "memory"); } \
        asm volatile("global_load_dword %0, %1, off" : "+v"(pfd) : "v"((const char*)(QKM + ch_ * 4096) + lane * 128) : "memory"); \
        asm volatile("global_load_dword %0, %1, off" : "+v"(pfd) : "v"((const char*)(UT + (ch_ * 128 + part * 64) * 64) + lane * 128) : "memory"); } while (0)
    __syncthreads();
    if (cw) {
        f32x4 S[8];
#pragma unroll
        for (int t = 0; t < 8; ++t) S[t] = (f32x4){0.f, 0.f, 0.f, 0.f};
        const int uoff = SC_OFF_U + (16 * wid + fr) * 144 + 8 * fq;
        LDS_BARRIER();
        for (int n = 0; n < 64; n += 2) {
            dn_scan_step(lds, S, lds + uoff, __shfl(gle_all, n), MIX + ((size_t)b * 4096 + n * 64 + fr) * 1024 + h * 128 + n0 + 4 * fq, fr, fq);
            LDS_BARRIER();
            dn_scan_step(lds + SC_BUFSZ, S, lds + SC_BUFSZ + uoff, __shfl(gle_all, n + 1), MIX + ((size_t)b * 4096 + (n + 1) * 64 + fr) * 1024 + h * 128 + n0 + 4 * fq, fr, fq);
            LDS_BARRIER();
        }
        float* So = lout(p) + O_SP + ((size_t)(l * 8 + b) * 4 + h) * 16384;
#pragma unroll
        for (int t = 0; t < 8; ++t)
#pragma unroll
            for (int jj = 0; jj < 4; ++jj) So[(16 * t + 4 * fq + jj) * 128 + n0 + fr] = S[t][jj];
    } else if (wid < 7) {
        u32x4 sa[24], sb[24];
        DN_LOAD(sa, 0); DN_WRITE(sa, 0); DN_LOAD(sa, 1);
        LDS_BARRIER();
        for (int n = 0; n < 64; n += 2) {
            if (n + 2 < 64) DN_LOAD(sb, n + 2);
            DN_WRITE(sa, 1);
            LDS_BARRIER();
            if (n + 3 < 64) DN_LOAD(sa, n + 3);
            if (n + 2 < 64) DN_WRITE(sb, 0);
            LDS_BARRIER();
        }
    } else {
        constexpr int SCAN_PF = 5;
        unsigned pfd = 0u;
#pragma unroll
        for (int m = 2; m < 2 + SCAN_PF; ++m) DN_TOUCH(m);
        LDS_BARRIER();
        for (int n = 0; n < 64; ++n) {
            if (n + 2 + SCAN_PF < 64) DN_TOUCH(n + 2 + SCAN_PF);
            asm volatile("s_waitcnt vmcnt(32)" ::: "memory");
            LDS_BARRIER();
        }
        asm volatile("s_waitcnt vmcnt(0)" ::: "memory");
        asm volatile("" :: "v"(pfd));
    }
#undef DN_LOAD
#undef DN_WRITE
#undef DN_TOUCH
}

__device__ __forceinline__ void swa_attn_unit(const Params& p, LAS unsigned char* lds, int l, int unit) {
    const int tid = ltid(), wid = tid >> 6, lane = tid & 63, fr = lane & 15, fq = lane >> 4;
    const int hk = unit & 1, nb = (unit >> 1) & 31, b = unit >> 6;
    const bf16_t* P = (const bf16_t*)(lws(p) + WS_HID); bf16_t* MIX = (bf16_t*)(lws(p) + WS_H);
    LAS unsigned char* Ks = lds; LAS unsigned char* Vt = lds + 36864;
    LDS_BARRIER();
#pragma unroll
    for (int it = 0; it < 4; ++it) {
        const int c = tid + 512 * it;
        { const int kj = c >> 3, c8 = c & 7; int tl = (nb - 1) * 128 + kj; if (tl < 0) tl += 128;
          const u32x4 kv = *(const u32x4*)(P + ((size_t)b * 4096 + tl) * PW + SK + hk * 64 + c8 * 8);
          *(LAS u32x4*)(Ks + kj * 144 + c8 * 16) = kv; }
        { const int kj = c & 255, c8 = c >> 8; int tl = (nb - 1) * 128 + kj; if (tl < 0) tl += 128;
          const u32x4 vv = *(const u32x4*)(P + ((size_t)b * 4096 + tl) * PW + SV + hk * 64 + c8 * 8);
#pragma unroll
          for (int e = 0; e < 8; ++e) *(LAS bf16_t*)(Vt + (c8 * 8 + e) * 528 + kj * 2) = (bf16_t)((e & 1) ? (vv[e >> 1] >> 16) : (vv[e >> 1] & 0xffffu)); }
    }
    LDS_BARRIER();
    for (int it = 0; it < 4; ++it) {
        const int combo = wid * 4 + it, hq = combo >> 3, qt = combo & 7, head = hk * 4 + hq;
        const size_t tq = (size_t)b * 4096 + nb * 128 + 16 * qt + fr;
        bf16x8 qf[2];
#pragma unroll
        for (int ks = 0; ks < 2; ++ks) qf[ks] = *(const bf16x8*)(P + tq * PW + SQ + head * 64 + 32 * ks + 8 * fq);
        f32x4 sc[10];
#pragma unroll
        for (int u = 0; u < 9; ++u) {
            f32x4 a = {0.f, 0.f, 0.f, 0.f};
#pragma unroll
            for (int ks = 0; ks < 2; ++ks) { const bf16x8 kf = *(const LAS bf16x8*)(Ks + (16 * (qt + u) + fr) * 144 + (32 * ks + 8 * fq) * 2); a = MFMA16(kf, qf[ks], a); }
            sc[u] = a;
        }
        sc[9] = (f32x4){0.f, 0.f, 0.f, 0.f};
        const float sink = p.in[21][l * 8 + head];
        float m = sink;
#pragma unroll
        for (int u = 0; u < 9; ++u)
#pragma unroll
            for (int jj = 0; jj < 4; ++jj) {
                const int kk = 16 * u + 4 * fq + jj;
                const bool valid = (kk >= fr) && (kk <= fr + 128) && (nb > 0 || 16 * qt + kk >= 128);
                sc[u][jj] = valid ? sc[u][jj] : -__builtin_inff();
                m = fmaxf(m, sc[u][jj]);
            }
        m = fmaxf(m, __shfl_xor(m, 16)); m = fmaxf(m, __shfl_xor(m, 32));
        float sum = 0.f;
#pragma unroll
        for (int u = 0; u < 9; ++u)
#pragma unroll
            for (int jj = 0; jj < 4; ++jj) { const float pv = __expf(sc[u][jj] - m); sc[u][jj] = pv; sum += pv; }
        sum += __shfl_xor(sum, 16); sum += __shfl_xor(sum, 32);
        sum += __expf(sink - m);
        const float rinv = 1.0f / sum;
        f32x4 o[4];
#pragma unroll
        for (int dt = 0; dt < 4; ++dt) o[dt] = (f32x4){0.f, 0.f, 0.f, 0.f};
#pragma unroll
        for (int s = 0; s < 5; ++s) {
            const bf16x8 pf = pack_frag(sc[2 * s], sc[2 * s + 1]);
            const int kb = 16 * (qt + 2 * s), kb2 = (s < 4) ? kb + 16 : kb;
#pragma unroll
            for (int dt = 0; dt < 4; ++dt) {
                const u32x2 lo = *(const LAS u32x2*)(Vt + (16 * dt + fr) * 528 + (kb + 4 * fq) * 2), hi = *(const LAS u32x2*)(Vt + (16 * dt + fr) * 528 + (kb2 + 4 * fq) * 2);
                o[dt] = MFMA16(mk8(lo[0], lo[1], hi[0], hi[1]), pf, o[dt]);
            }
        }
#pragma unroll
        for (int dt = 0; dt < 4; ++dt) {
            u32x2 w = {pk2(o[dt][0] * rinv, o[dt][1] * rinv), pk2(o[dt][2] * rinv, o[dt][3] * rinv)};
            *(u32x2*)(MIX + tq * 1024 + 512 + head * 64 + 16 * dt + 4 * fq) = w;
        }
    }
}

__device__ __forceinline__ void phase_gnorm(const Params& p, int l) {
    const int tid = ltid(), wid = tid >> 6, lane = tid & 63;
    const bf16_t* P = (const bf16_t*)(lws(p) + WS_HID); bf16_t* MIX = (bf16_t*)(lws(p) + WS_H);
    const float* nw = p.in[18] + l * 128 + ((8 * lane) & 127);
    const f32x4 n0 = *(const f32x4*)nw, n1 = *(const f32x4*)(nw + 4);
    const int nwv = gridDim.x * 8;
    for (int ck = lbid() * 8 + wid; ck < MPR / 16; ck += nwv) {
        const int r0 = ck * 16;
        u32x4 ovn = *(const u32x4*)(MIX + (size_t)r0 * 1024 + 8 * lane), zvn = *(const u32x4*)(P + (size_t)r0 * PW + ZC + 8 * lane);
#pragma unroll 1
        for (int k = 0; k < 16; ++k) {
            const int r = r0 + k;
            bf16_t* mp = MIX + (size_t)r * 1024 + 8 * lane;
            const u32x4 ov = ovn, zv = zvn;
            if (k + 1 < 16) { ovn = *(const u32x4*)(mp + 1024); zvn = *(const u32x4*)(P + (size_t)(r + 1) * PW + ZC + 8 * lane); }
            float o[8], z[8];
#pragma unroll
            for (int e = 0; e < 4; ++e) { o[2 * e] = lo_bf(ov[e]); o[2 * e + 1] = hi_bf(ov[e]); z[2 * e] = lo_bf(zv[e]); z[2 * e + 1] = hi_bf(zv[e]); }
            float ss = 0.f;
#pragma unroll
            for (int e = 0; e < 8; ++e) ss += o[e] * o[e];
            ss = row16_sum(ss);
            const float rstd = rsqrtf(ss * (1.0f / 128.0f) + 1e-6f);
            float y[8];
#pragma unroll
            for (int e = 0; e < 8; ++e) y[e] = o[e] * rstd * (e < 4 ? n0[e] : n1[e - 4]) * silu_f(z[e]);
            u32x4 w = {pk2(y[0], y[1]), pk2(y[2], y[3]), pk2(y[4], y[5]), pk2(y[6], y[7])};
            *(u32x4*)mp = w;
        }
    }
}

__global__ void __launch_bounds__(512, 2) hymba_megakernel(Params p) {
    extern __shared__ __attribute__((aligned(16))) unsigned char shm[];
    LAS unsigned char* lds = (LAS unsigned char*)shm;
    volatile LAS unsigned* xbst = (volatile LAS unsigned*)(lds + LDS_XB);
    if (threadIdx.x < 4) xbst[threadIdx.x] = 0u;
    __syncthreads();
    (void)xcd_barrier_post((unsigned*)(p.ws + WS_BAR), xbst);
    for (int ph = p.ph_lo; ph < p.ph_hi; ++ph) {
        const int tid = ltid();
        unsigned char* wsb = lws(p);
        bf16_t* wt = (bf16_t*)(wsb + WS_WT);
        bf16_t* H = (bf16_t*)(wsb + WS_H); bf16_t* HID = (bf16_t*)(wsb + WS_HID);
        float* MOD = (float*)(wsb + WS_MOD);
        float* X = lout(p);
        const int l = ph < 2 ? 0 : (ph - 2) / 12, sub = ph < 2 ? -1 : (ph - 2) % 12;
        const bool first = (l == 0 && sub < 3);
        const float* xp = first ? p.in[0] : X; const float* xs = first ? p.in[1] : X + (size_t)MPR * 1024;
        const bf16_t* wl = wt + l * LW_EL;
        const bool is_gemm = (ph == 1) || sub == 1 || sub == 2 || sub == 4 || sub == 8 || sub == 10 || sub == 11;
        if (is_gemm) {
            {
                EpiAny E{}; const bf16_t* A = H; const bf16_t* Bt; int Mg = MPR, N, K = 1024;
                E.xp = xp; E.xs = xs; E.X = X; E.O = HID; E.s = 0.5f; E.gate = MOD;
                if (ph == 1) { E.kind = 3; A = (const bf16_t*)(lws(p) + WS_SC); Bt = (const bf16_t*)(lws(p) + WS_ADA); Mg = 256; N = MODW; E.X = MOD; E.gate = p.in[9]; }
                else if (sub == 1) { E.kind = 0; Bt = wl + W_GU1; N = 5632; }
                else if (sub == 10) { E.kind = 0; Bt = wl + W_GU2; N = 5632; }
                else if (sub == 2) { E.kind = 1; A = HID; Bt = wl + W_DN1; N = 1024; K = 2816; E.gate = MOD + l * 9216 + 2 * 1024; }
                else if (sub == 11) { E.kind = 1; A = HID; Bt = wl + W_DN2; N = 1024; K = 2816; E.gate = MOD + l * 9216 + 8 * 1024; }
                else if (sub == 8) { E.kind = 1; Bt = wl + W_OUT; N = 1024; E.s = 1.0f; E.gate = MOD + l * 9216 + 5 * 1024; }
                else { E.kind = 2; Bt = wl + W_IN; N = 2816; }
                run_gemm(lds, A, Bt, Mg, N, K, E);
                if (ph != 1) skinny_gemm(E, A, Bt, N, K);
            }
        }
        else if (ph == 0) { phase_prep(p, lds); }
        else if (sub == 0 || sub == 3 || sub == 9) { phase_norm(p, lds, l, sub == 0 ? 0 : (sub == 3 ? 1 : 2), xp, xs, (l == 0 && sub == 0) ? X : nullptr); }
        else if (sub == 5) {
            swa_prep(p, l);
            for (int ch = lbid(); ch < 2048; ch += gridDim.x) { const int nx = ch + (int)gridDim.x; dn_chunk_prep(p, lds, l, ch, nx < 2048 ? nx : -1); }
            for (int idx = lbid() * 512 + tid; idx < 8 * 3 * 1536; idx += gridDim.x * 512) {
                const int cc = idx % 1536, j = (idx / 1536) % 3, b = idx / 4608;
                lout(p)[O_CVP + (size_t)l * 36864 + idx] = bf2f(HID[((size_t)b * 4096 + 4093 + j) * PW + cc]);
            }
        }
        else if (sub == 6) {
            const int G = gridDim.x;
            if (G > SCAN_NBLK) { if (lbid() < SCAN_NBLK) { dn_scan(p, lds, l, lbid()); } else {
                for (int u = lbid() - SCAN_NBLK; u < 512; u += G - SCAN_NBLK) { swa_attn_unit(p, lds, l, u); }
                for (int it = G - 1 - lbid(); it < 640; it += G - SCAN_NBLK) { if (it < 512) sample_dn(p, lds, l, it); else sample_swa(p, lds, l, it - 512); }
            } }
            else { for (int c = lbid(); c < SCAN_NBLK; c += G) dn_scan(p, lds, l, c); for (int u = lbid(); u < 512; u += G) swa_attn_unit(p, lds, l, u); for (int it = lbid(); it < 640; it += G) { if (it < 512) sample_dn(p, lds, l, it); else sample_swa(p, lds, l, it - 512); } }
        }
        else if (sub == 7) phase_gnorm(p, l);
        if (ph + 1 < p.ph_hi && p.coop) { if (ph == 0) cg::this_grid().sync(); else { XcdBarrier xb; xb.bar = (unsigned*)(lws(p) + WS_BAR); xb.x = xb_xcc_id(); xb.st = (volatile LAS unsigned*)(lds + LDS_XB); xcd_barrier(xb); } }
    }
}

#ifndef MK_MULTI
#define MK_MULTI 0
#endif
extern "C" void kernel_launch(void* const* d_in, const int* in_sizes, int n_in, void* d_out, int out_size, void* d_ws, size_t ws_size, hipStream_t stream) {
    static int grid = 0;
    if (grid == 0) {
        if (n_in != 26 || ws_size < WS_TOTAL) { fprintf(stderr, "kernel_launch: n_in %d ws %zu (need %zu)\n", n_in, ws_size, (size_t)WS_TOTAL); grid = -1; return; }
        int dev = 0, cus = 0, per_cu = 0;
        hipGetDevice(&dev);
        hipDeviceGetAttribute(&cus, hipDeviceAttributeMultiprocessorCount, dev);
        if (hipFuncSetAttribute((const void*)hymba_megakernel, hipFuncAttributeMaxDynamicSharedMemorySize, LDS_BYTES) != hipSuccess) { fprintf(stderr, "kernel_launch: hipFuncSetAttribute failed\n"); grid = -1; return; }
        if (hipOccupancyMaxActiveBlocksPerMultiprocessor(&per_cu, (const void*)hymba_megakernel, 512, LDS_BYTES) != hipSuccess || per_cu < 1) { fprintf(stderr, "kernel_launch: occupancy query says %d\n", per_cu); per_cu = 1; }
        (void)hipGetLastError();
        grid = cus * 1;
        if (grid < 1) grid = 256;
    }
    if (grid < 0) return;
    (void)hipMemsetAsync((unsigned char*)d_ws + WS_BAR, 0, 16384, stream);
    Params p{};
    for (int i = 0; i < 26; ++i) p.in[i] = (const float*)d_in[i];
    p.out = (float*)d_out; p.ws = (unsigned char*)d_ws;
#if MK_MULTI
    for (int ph = 0; ph < NPHASE; ++ph) { p.ph_lo = ph; p.ph_hi = ph + 1; p.coop = 0; hipLaunchKernelGGL(hymba_megakernel, dim3(grid), dim3(512), LDS_BYTES, stream, p); }
#else
    p.ph_lo = 0; p.ph_hi = NPHASE; p.coop = 1;
    void* args[] = {&p};
    hipError_t e = hipLaunchCooperativeKernel((const void*)hymba_megakernel, dim3(grid), dim3(512), args, LDS_BYTES, stream);
    if (e != hipSuccess) fprintf(stderr, "cooperative launch failed: %s (grid %d)\n", hipGetErrorString(e), grid);
#endif
}
```

```cpp
#include <hip/hip_runtime.h>
#include <hip/hip_cooperative_groups.h>
#include <cstdio>
namespace cg = cooperative_groups;
#include <hip/hip_runtime.h>
namespace pg8 {
#define PG8_LAS __attribute__((address_space(3)))
typedef unsigned short bf16_t;
typedef short bf16x8 __attribute__((ext_vector_type(8)));
typedef float f32x4 __attribute__((ext_vector_type(4)));
typedef unsigned u32x4 __attribute__((ext_vector_type(4)));
constexpr int BM = 256, BK = 64, HALF = 128, HTB = HALF * BK * 2  , STAGE_BYTES = 8 * HTB, NXCD = 8, WGM = 8;

__host__ __device__ __forceinline__ int lds_byte(int r, int c) { const int st = (r >> 4) * 2 + (c >> 5), rr = r & 15, cc = c & 31, ob = rr * 64 + cc * 2; return st * 1024 + (ob ^ (((ob >> 9) & 1) << 5)); }
__host__ __device__ __forceinline__ void stage_rc(int b, int& R, int& C) { const int st = b / 1024, sb = b % 1024, swz = sb ^ (((sb >> 9) & 1) << 5); R = (st >> 1) * 16 + swz / 64; C = (st & 1) * 32 + (swz % 64) / 2; }
__host__ __device__ __forceinline__ int perm32(int rho) { const int n = rho >> 4, i = rho & 15; return 8 * (i >> 2) + 4 * n + (i & 3); }

struct Unit { int pm, pn; };
struct Gemm { const bf16_t* A; const bf16_t* Bt; int M, N, K; };

struct StaticOrder {
    int nM, nN, nwg, G, c;
    __host__ __device__ void init(int M, int N, int G_, int c_) { nM = M / BM; nN = N / BM; nwg = nM * nN; G = G_; c = c_; }
    __host__ __device__ bool next(int i, Unit& u) const {
        const long L = (long)i * G + c; if (L >= nwg) return false;
        int wgid = (int)L; { const int q = nwg / NXCD, r = nwg % NXCD, xcd = wgid % NXCD, off = wgid / NXCD; wgid = (xcd < r ? xcd * (q + 1) : r * (q + 1) + (xcd - r) * q) + off; }
        const int nig = WGM * nN, gid = wgid / nig, fm = gid * WGM, gsz = (nM - fm) < WGM ? (nM - fm) : WGM;
        u.pm = fm + ((wgid % nig) % gsz); u.pn = (wgid % nig) / gsz; return true;
    }
    __device__ __forceinline__ void a_ready(const Unit&) const {}
    __device__ __forceinline__ void done(const Unit&) const {}
};
__device__ __forceinline__ unsigned cvt_pk_bf16(float lo, float hi) { unsigned r; asm volatile("v_cvt_pk_bf16_f32 %0, %1, %2" : "=v"(r) : "v"(lo), "v"(hi)); return r; }
template <class Epi, class Sched, bool STAMP = false>
__device__ __forceinline__ void gemm_phase(PG8_LAS unsigned char* lds, const Gemm g, const Sched& S, const Epi& E, unsigned long long* stamps) {
    int tid_ = threadIdx.x; asm volatile("" : "+v"(tid_)); const int tid = tid_, wid = __builtin_amdgcn_readfirstlane(tid >> 6), lane = tid & 63, wr = wid >> 2, wc = wid & 3, fr = lane & 15, fq = lane >> 4;
    const int K = g.K, nt = K / BK;
    int ts_lo = 0, ts_hi = 0, nts = 0; const unsigned long long rt_entry = STAMP ? (unsigned long long)wall_clock64() : 0ull;
#define PG8_STAMP() do { if (STAMP && wid == 0 && nts < 64) { const unsigned long long _c = (unsigned long long)clock64(); \
        ts_lo = (lane == nts) ? (int)(unsigned)_c : ts_lo; ts_hi = (lane == nts) ? (int)(unsigned)(_c >> 32) : ts_hi; ++nts; } } while (0)
    PG8_STAMP();
    unsigned voffA[2], voffB[2];
#pragma unroll
    for (int i = 0; i < 2; ++i) { int R, C; stage_rc(tid * 16 + i * 8192, R, C); const int Rb = Epi::PERM ? ((R & ~31) + perm32(R & 31)) : R;
        voffA[i] = (unsigned)(R * K + C) * 2u; voffB[i] = (unsigned)(Rb * K + C) * 2u; }
    const size_t kstep = (size_t)(BK * 2);
    const size_t hstep = (size_t)HALF * K * 2;
    const size_t tstep = 2 * hstep;
    const unsigned ldsw = (unsigned)wid * 1024u;
    const int aoff = lds_byte(wr * 64 + fr, fq * 8), boff = lds_byte(wc * 32 + fr, fq * 8);
#define PG8_SA(b, h) (((b) * 2 + (h)) * HTB)
#define PG8_SB(b, h) ((4 + (b) * 2 + (h)) * HTB)
#define PG8_STAGE(bufoff, gbase, voff) do { _Pragma("unroll") for (int _i = 0; _i < 2; ++_i) \
        __builtin_amdgcn_global_load_lds((const unsigned*)((const char*)(gbase) + (voff)[_i]), (PG8_LAS unsigned*)(lds + (bufoff) + ldsw + _i * 8192), 16, 0, 0); } while (0)
#define PG8_LDA(dst, b, h) do { _Pragma("unroll") for (int m = 0; m < 4; ++m) _Pragma("unroll") for (int k = 0; k < 2; ++k) dst[m][k] = *(const PG8_LAS bf16x8*)(lds + PG8_SA(b, h) + aoff + m * 2048 + k * 1024); } while (0)
#define PG8_LDB(dst, b, h) do { _Pragma("unroll") for (int n = 0; n < 2; ++n) _Pragma("unroll") for (int k = 0; k < 2; ++k) dst[n][k] = *(const PG8_LAS bf16x8*)(lds + PG8_SB(b, h) + boff + n * 2048 + k * 1024); } while (0)
#define PG8_MMA(ai, bj, At, Bt) do { __builtin_amdgcn_s_setprio(1); _Pragma("unroll") for (int m = 0; m < 4; ++m) _Pragma("unroll") for (int n = 0; n < 2; ++n) _Pragma("unroll") for (int k = 0; k < 2; ++k) \
        acc[ai][bj][m][n] = __builtin_amdgcn_mfma_f32_16x16x32_bf16(Bt[n][k], At[m][k], acc[ai][bj][m][n], 0, 0, 0); __builtin_amdgcn_s_setprio(0); } while (0)
#define PG8_WAIT_V(n) asm volatile("s_waitcnt vmcnt(" #n ")" ::: "memory")
#define PG8_WAIT_L(n) asm volatile("s_waitcnt lgkmcnt(" #n ")" ::: "memory")
#define PG8_BAR __builtin_amdgcn_s_barrier()
#define PG8_SCHED __builtin_amdgcn_sched_barrier(0)
    Unit cur, nxt; int ui = 0;
    if (!S.next(0, cur)) return;
    f32x4 acc[2][2][4][2];
#pragma unroll
    for (int a = 0; a < 2; ++a)
#pragma unroll
        for (int b = 0; b < 2; ++b)
#pragma unroll
            for (int m = 0; m < 4; ++m)
#pragma unroll
                for (int n = 0; n < 2; ++n) acc[a][b][m][n] = (f32x4){0.f, 0.f, 0.f, 0.f};
    bf16x8 At[4][2], B0[2][2], B1[2][2];
    const char* cA = (const char*)g.A + (size_t)cur.pm * tstep; const char* cB = (const char*)g.Bt + (size_t)cur.pn * tstep;
    S.a_ready(cur);
    PG8_STAGE(PG8_SB(0, 0), cB, voffB); PG8_STAGE(PG8_SA(0, 0), cA, voffA); PG8_STAGE(PG8_SB(0, 1), cB + hstep, voffB); PG8_STAGE(PG8_SA(0, 1), cA + hstep, voffA);
    if (wr == 1) PG8_BAR;
    PG8_WAIT_V(4); PG8_BAR;
    PG8_STAGE(PG8_SB(1, 0), cB + kstep, voffB); PG8_STAGE(PG8_SA(1, 0), cA + kstep, voffA); PG8_STAGE(PG8_SB(1, 1), cB + hstep + kstep, voffB);
    PG8_WAIT_V(6); PG8_BAR;
    PG8_STAMP();
    for (;;) {
        const bool has_next = S.next(ui + 1, nxt);
        const char* nA = has_next ? (const char*)g.A + (size_t)nxt.pm * tstep : cA; const char* nB = has_next ? (const char*)g.Bt + (size_t)nxt.pn * tstep : cB;
        for (int t = 0; t < nt; t += 2) {
            const bool last = (t == nt - 2);
            const char* a1 = cA + (size_t)(t + 1) * kstep;
            const char* a2 = last ? nA : cA + (size_t)(t + 2) * kstep; const char* b2 = last ? nB : cB + (size_t)(t + 2) * kstep;
            const char* a3 = a2 + kstep; const char* b3 = b2 + kstep;
            if (last && has_next) S.a_ready(nxt);
            PG8_LDB(B0, 0, 0); PG8_SCHED; PG8_LDA(At, 0, 0); PG8_STAGE(PG8_SA(1, 1), a1 + hstep, voffA);
            PG8_WAIT_L(8); PG8_BAR; PG8_WAIT_L(0); PG8_MMA(0, 0, At, B0); PG8_BAR; PG8_SCHED;
            PG8_LDB(B1, 0, 1); PG8_STAGE(PG8_SB(0, 0), b2, voffB);
            PG8_BAR; PG8_WAIT_L(0); PG8_MMA(0, 1, At, B1); PG8_BAR;
            PG8_LDA(At, 0, 1); PG8_STAGE(PG8_SA(0, 0), a2, voffA);
            PG8_BAR; PG8_WAIT_L(0); PG8_MMA(1, 0, At, B0); PG8_BAR; PG8_SCHED;
            PG8_STAGE(PG8_SB(0, 1), b2 + hstep, voffB);
            PG8_WAIT_V(6); PG8_BAR; PG8_MMA(1, 1, At, B1); PG8_BAR;
            PG8_LDB(B0, 1, 0); PG8_SCHED; PG8_LDA(At, 1, 0); PG8_STAGE(PG8_SA(0, 1), a2 + hstep, voffA);
            PG8_WAIT_L(8); PG8_BAR; PG8_WAIT_L(0); PG8_MMA(0, 0, At, B0); PG8_BAR; PG8_SCHED;
            PG8_LDB(B1, 1, 1); PG8_STAGE(PG8_SB(1, 0), b3, voffB);
            PG8_BAR; PG8_WAIT_L(0); PG8_MMA(0, 1, At, B1); PG8_BAR;
            PG8_LDA(At, 1, 1); PG8_STAGE(PG8_SA(1, 0), a3, voffA);
            PG8_BAR; PG8_WAIT_L(0); PG8_MMA(1, 0, At, B0); PG8_BAR; PG8_SCHED;
            PG8_STAGE(PG8_SB(1, 1), b3 + hstep, voffB);
            PG8_WAIT_V(6); PG8_BAR; PG8_MMA(1, 1, At, B1); PG8_BAR;
        }
        PG8_STAMP();
        if constexpr (!Epi::AFTER_DRAIN) { E(acc, cur, wr, wc, fr, fq); S.done(cur); }
        PG8_STAMP();
        if (!has_next) break;
#pragma unroll
        for (int a = 0; a < 2; ++a)
#pragma unroll
            for (int b = 0; b < 2; ++b)
#pragma unroll
                for (int m = 0; m < 4; ++m)
#pragma unroll
                    for (int n = 0; n < 2; ++n) acc[a][b][m][n] = (f32x4){0.f, 0.f, 0.f, 0.f};
        cur = nxt; cA = nA; cB = nB; ++ui;
    }
    PG8_WAIT_V(0);
    if (wr == 0) PG8_BAR;
    PG8_BAR;
    if constexpr (Epi::AFTER_DRAIN) { E.fused(acc, cur, wr, wc, fr, fq, lds, wid, lane); S.done(cur); }
    PG8_STAMP();
    if (STAMP && wid == 0) { stamps[lane] = lane < nts ? (((unsigned long long)(unsigned)ts_hi << 32) | (unsigned)ts_lo) : 0ull;
        if (lane == 62) stamps[62] = rt_entry; if (lane == 63) stamps[63] = (unsigned long long)wall_clock64(); }
#undef PG8_STAMP
#undef PG8_SA
#undef PG8_SB
#undef PG8_STAGE
#undef PG8_LDA
#undef PG8_LDB
#undef PG8_MMA
#undef PG8_WAIT_V
#undef PG8_WAIT_L
#undef PG8_BAR
#undef PG8_SCHED
}
}

using pg8::bf16_t; using pg8::bf16x8; using pg8::f32x4; using pg8::u32x4;
typedef unsigned u32x2 __attribute__((ext_vector_type(2)));
typedef float f32x2 __attribute__((ext_vector_type(2)));
#define LAS __attribute__((address_space(3)))

constexpr int MPR = 32768, MTOT = 32896, MPAD = 33024, PW = 2816;
constexpr int MODW = 18432, NMB = 136;
constexpr int ZC = 1536, SQ = 2048, SK = 2560, SV = 2688;
constexpr size_t O_CVP = 33685504, O_SP = 33759232, O_KP = 34807808, O_VP = 35069952, O_CVS = 35332096, O_SS = 36511744, O_KS = 53288960, O_VS = 57483264;
constexpr size_t LW_EL = 21233664;
constexpr size_t W_GU1 = 0, W_DN1 = 5767168, W_IN = 8650752, W_OUT = 11534336, W_GU2 = 12582912, W_DN2 = 18350080;
constexpr size_t WS_WT = 0;
constexpr size_t WS_ADA = 2 * LW_EL * 2;
constexpr size_t WS_QKM = WS_ADA;
constexpr size_t WS_GLE = WS_ADA + 16777216;
constexpr size_t WS_PAB = WS_GLE + 8192;
constexpr size_t WS_SC = WS_ADA + 37748736;
constexpr size_t WS_MOD = WS_SC + 524288;
constexpr size_t WS_H = WS_MOD + 10027008;
constexpr size_t WS_HID = WS_H + (size_t)MPAD * 1024 * 2;
constexpr size_t WS_UT = WS_HID + (size_t)MPAD * 2816 * 2;
constexpr size_t WS_W = WS_UT + 33554432;
constexpr size_t WS_QD = WS_W + 33554432;
constexpr size_t WS_KDT = WS_QD + 33554432;
constexpr size_t WS_END = WS_KDT + 33554432;
constexpr size_t WS_BAR = WS_END;
constexpr size_t WS_TOTAL = WS_BAR + 16384;
static_assert(WS_TOTAL <= 536870912ull, "workspace budget");
constexpr int LDS_BYTES = 147456;
constexpr int LDS_XB = LDS_BYTES - 16;
constexpr int NPHASE = 26;

struct Params {
    const float* in[26];
    float* out;
    unsigned char* ws;
    int ph_lo, ph_hi, coop, pad;
};


__device__ __forceinline__ int ltid() { int t = threadIdx.x; asm volatile("" : "+v"(t)); return t; }
__device__ __forceinline__ int lbid() { int t = blockIdx.x; asm volatile("" : "+s"(t)); return t; }
__device__ __forceinline__ size_t lzero() { size_t z = 0; asm volatile("" : "+s"(z)); return z; }
__device__ __forceinline__ unsigned char* lws(const Params& p) { return p.ws + lzero(); }
__device__ __forceinline__ float* lout(const Params& p) { return p.out + lzero(); }

__device__ __forceinline__ float bf2f(unsigned short h) { return __uint_as_float(((unsigned)h) << 16); }
__device__ __forceinline__ unsigned short f2bf(float f) { unsigned u = __float_as_uint(f); u += 0x7fffu + ((u >> 16) & 1u); return (unsigned short)(u >> 16); }
typedef __bf16 bf16v2 __attribute__((ext_vector_type(2)));
__device__ __forceinline__ unsigned pk2(float lo, float hi) { f32x2 v = {lo, hi}; bf16v2 b = __builtin_convertvector(v, bf16v2); return __builtin_bit_cast(unsigned, b); }
__device__ __forceinline__ float lo_bf(unsigned u) { return __uint_as_float(u << 16); }
__device__ __forceinline__ float hi_bf(unsigned u) { return __uint_as_float(u & 0xffff0000u); }
__device__ __forceinline__ float silu_f(float x) { return x * __builtin_amdgcn_rcpf(1.0f + __expf(-x)); }
template <int CTRL> __device__ __forceinline__ float dpp_f(float v) { return __builtin_bit_cast(float, __builtin_amdgcn_update_dpp(0, __builtin_bit_cast(int, v), CTRL, 0xf, 0xf, true)); }
__device__ __forceinline__ float row16_sum(float v) { v += dpp_f<0xB1>(v); v += dpp_f<0x4E>(v); v += dpp_f<0x141>(v); v += dpp_f<0x140>(v); return v; }
__device__ __forceinline__ float wave_sum(float v) {
    v = row16_sum(v);
    const float a = __builtin_bit_cast(float, __builtin_amdgcn_readlane(__builtin_bit_cast(int, v), 15)), b = __builtin_bit_cast(float, __builtin_amdgcn_readlane(__builtin_bit_cast(int, v), 31));
    const float c = __builtin_bit_cast(float, __builtin_amdgcn_readlane(__builtin_bit_cast(int, v), 47)), d = __builtin_bit_cast(float, __builtin_amdgcn_readlane(__builtin_bit_cast(int, v), 63));
    return (a + b) + (c + d);
}
__device__ __forceinline__ float wave_max(float v) {
#pragma unroll
    for (int o = 32; o; o >>= 1) v = fmaxf(v, __shfl_xor(v, o));
    return v;
}
__device__ __forceinline__ bf16x8 mk8(unsigned a, unsigned b, unsigned c, unsigned d) { u32x4 w = {a, b, c, d}; return __builtin_bit_cast(bf16x8, w); }
__device__ __forceinline__ bf16x8 pack_frag(const f32x4& a, const f32x4& b) { return mk8(pk2(a[0], a[1]), pk2(a[2], a[3]), pk2(b[0], b[1]), pk2(b[2], b[3])); }
__device__ __forceinline__ bf16x8 rd_perm(const LAS unsigned char* p, int fq) {
    u32x2 lo = *(const LAS u32x2*)(p + 8 * fq), hi = *(const LAS u32x2*)(p + 32 + 8 * fq);
    return mk8(lo[0], lo[1], hi[0], hi[1]);
}
__device__ __forceinline__ int kpos(int k) { const int kk = k & 31; return (k & ~31) + ((kk & 12) << 1) + ((kk & 16) >> 2) + (kk & 3); }
#define LDS_BARRIER() do { asm volatile("s_waitcnt lgkmcnt(0)" ::: "memory"); __builtin_amdgcn_s_barrier(); asm volatile("" ::: "memory"); } while (0)
#define SCHED_FENCE() __builtin_amdgcn_sched_barrier(0)
#define MFMA16(a, b, c) __builtin_amdgcn_mfma_f32_16x16x32_bf16((a), (b), (c), 0, 0, 0)

#define XB_TMO      128
#define XB_XCNT(j)  (256  + 64 * (j))
#define XB_XSUB(j)  (1280 + 64 * (j))
#define XB_XGEN(j)  (2304 + 64 * (j))
#define XB_TOP      3328
#define XB_TOPGEN   3392
#define XCD_BAR_WORDS 3456
#define XB_SPIN_CAP (1u << 18)

__device__ __forceinline__ unsigned xb_ld(unsigned* p)              { return __hip_atomic_load(p, __ATOMIC_RELAXED, __HIP_MEMORY_SCOPE_AGENT); }
__device__ __forceinline__ unsigned xb_add(unsigned* p, unsigned v) { return __hip_atomic_fetch_add(p, v, __ATOMIC_RELAXED, __HIP_MEMORY_SCOPE_AGENT); }
__device__ __forceinline__ unsigned xb_xcc_id() { return (unsigned)__builtin_amdgcn_s_getreg((3 << 11) | 20) & 0xFu; }
#define XB_SPIN(cond, bar) do { unsigned _sp = 0; while (cond) { __builtin_amdgcn_s_sleep(1); \
    if ((++_sp & 255u) == 0u) { if (xb_ld(&(bar)[XB_TMO])) break; if (_sp > XB_SPIN_CAP) { atomicAdd(&(bar)[XB_TMO], 1u); break; } } } } while (0)

struct XcdBarrier {
    unsigned* bar; unsigned x;
    volatile LAS unsigned* st;
};

__device__ __forceinline__ XcdBarrier xcd_barrier_post(unsigned* bar, volatile LAS unsigned* st) {
    XcdBarrier b; b.bar = bar; b.x = xb_xcc_id(); b.st = st;
    if (threadIdx.x == 0) (void)xb_add(&bar[XB_XCNT(b.x)], 1u);
    return b;
}
__device__ __forceinline__ void xcd_barrier_complete(unsigned* bar, unsigned x, unsigned& nloc, unsigned& nx) {
    const unsigned G = gridDim.x * gridDim.y * gridDim.z;
    unsigned sum, cnt, mine, sp = 0u;
    for (;;) {
        sum = 0u; cnt = 0u; mine = 0u;
#pragma unroll
        for (unsigned j = 0; j < 16; ++j) { const unsigned c = xb_ld(&bar[XB_XCNT(j)]); sum += c; cnt += (c > 0u) ? 1u : 0u; mine = (j == x) ? c : mine; }
        if (sum == G) break;
        __builtin_amdgcn_s_sleep(1);
        if ((++sp & 255u) == 0u) { if (xb_ld(&bar[XB_TMO])) break; if (sp > XB_SPIN_CAP) { atomicAdd(&bar[XB_TMO], 1u); break; } }
    }
    nloc = mine > 0u ? mine : 1u; nx = cnt > 0u ? cnt : 1u;
}

__device__ __forceinline__ void xcd_barrier(const XcdBarrier& b) {
    asm volatile("s_waitcnt vmcnt(0)" ::: "memory");
    __syncthreads();
    if (threadIdx.x == 0) {
        unsigned* bar = b.bar;
        __builtin_amdgcn_s_waitcnt(0);
        unsigned nloc = b.st[0], nx = b.st[1];
        if (nloc == 0u) { xcd_barrier_complete(bar, b.x, nloc, nx); b.st[0] = nloc; b.st[1] = nx; }
        const unsigned old = xb_add(&bar[XB_XSUB(b.x)], 1u);
        const unsigned gen = old / nloc;
        if (old + 1u == (gen + 1u) * nloc) {
            __builtin_amdgcn_fence(__ATOMIC_RELEASE, "agent");
            asm volatile("s_waitcnt vmcnt(0)" ::: "memory");
            const unsigned og = xb_add(&bar[XB_TOP], 1u);
            const unsigned tg = og / nx;
            if (og + 1u == (tg + 1u) * nx) xb_add(&bar[XB_TOPGEN], 1u);
            else XB_SPIN(xb_ld(&bar[XB_TOPGEN]) == tg, bar);
            __builtin_amdgcn_fence(__ATOMIC_ACQUIRE, "agent");
            xb_add(&bar[XB_XGEN(b.x)], 1u);
            asm volatile("s_waitcnt vmcnt(0)" ::: "memory");
        } else {
            XB_SPIN(xb_ld(&bar[XB_XGEN(b.x)]) == gen, bar);
            __builtin_amdgcn_fence(__ATOMIC_ACQUIRE, "agent");
            asm volatile("s_waitcnt vmcnt(0)" ::: "memory");
        }
    }
    __syncthreads();
}


__device__ __forceinline__ void phase_prep(const Params& p, LAS unsigned char* lds) {
    const int tid = ltid();
    bf16_t* wt = (bf16_t*)(lws(p) + WS_WT); bf16_t* ada = (bf16_t*)(lws(p) + WS_ADA);
    LAS float* tile = (LAS float*)lds;
    auto decode = [&](int id, const float*& srcp, size_t& sstride, bf16_t*& dstp) {
        const int l = id / 7488; int r = id % 7488;
        const float* src; bf16_t* dst; int K, Nsrc, map, kt, nt;
        if (r < 2304) { src = p.in[8] + (size_t)l * 1024 * 9216; Nsrc = 9216; dst = ada + (size_t)l * 9216 * 1024; K = 1024; map = 0; kt = r & 15; nt = r >> 4; }
        else if (r < 3712) { r -= 2304; src = p.in[11] + (size_t)l * 1024 * 5632; Nsrc = 5632; dst = wt + l * LW_EL + W_GU1; K = 1024; map = 1; kt = r & 15; nt = r >> 4; }
        else if (r < 4416) { r -= 3712; src = p.in[12] + (size_t)l * 2816 * 1024; Nsrc = 1024; dst = wt + l * LW_EL + W_DN1; K = 2816; map = 0; kt = r % 44; nt = r / 44; }
        else if (r < 5120) { r -= 4416; src = p.in[14] + (size_t)l * 1024 * 2824; Nsrc = 2824; dst = wt + l * LW_EL + W_IN; K = 1024; map = 2; kt = r & 15; nt = r >> 4; }
        else if (r < 5376) { r -= 5120; src = p.in[22] + (size_t)l * 1024 * 1024; Nsrc = 1024; dst = wt + l * LW_EL + W_OUT; K = 1024; map = 0; kt = r & 15; nt = r >> 4; }
        else if (r < 6784) { r -= 5376; src = p.in[24] + (size_t)l * 1024 * 5632; Nsrc = 5632; dst = wt + l * LW_EL + W_GU2; K = 1024; map = 1; kt = r & 15; nt = r >> 4; }
        else { r -= 6784; src = p.in[25] + (size_t)l * 2816 * 1024; Nsrc = 1024; dst = wt + l * LW_EL + W_DN2; K = 2816; map = 0; kt = r % 44; nt = r / 44; }
        const int k0 = kt * 64, n0 = nt * 64;
        const int n = tid & 63, kk = tid >> 6, nn = n0 + n;
        const int sc = map == 0 ? nn : (map == 1 ? (((nn & 255) >> 7) * 2816 + (nn >> 8) * 128 + (nn & 127)) : (nn < 2048 ? nn : nn + 8));
        srcp = src + (size_t)(k0 + kk) * Nsrc + sc; sstride = (size_t)8 * Nsrc;
        dstp = dst + (size_t)(n0 + (tid >> 3)) * K + k0 + 8 * (tid & 7);
    };
    float vcur[8], vnext[8];
    const float* srcp; size_t sstride; bf16_t* dstp; bf16_t* dstn = nullptr;
    int id = lbid();
    if (id < 2 * 7488) { decode(id, srcp, sstride, dstp);
#pragma unroll
        for (int i = 0; i < 8; ++i) vcur[i] = srcp[i * sstride]; }
    for (; id < 2 * 7488; id += gridDim.x) {
        const int idn = id + gridDim.x;
        if (idn < 2 * 7488) { decode(idn, srcp, sstride, dstn);
#pragma unroll
            for (int i = 0; i < 8; ++i) vnext[i] = srcp[i * sstride]; }
        {
            const int n = tid & 63, kk = tid >> 6;
#pragma unroll
            for (int i = 0; i < 8; ++i) tile[(kk + 8 * i) * 65 + n] = vcur[i];
        }
        LDS_BARRIER();
        {
            const int nn = tid >> 3, k8 = tid & 7;
            float v[8];
#pragma unroll
            for (int j = 0; j < 8; ++j) v[j] = tile[(8 * k8 + j) * 65 + nn];
            u32x4 w = {pk2(v[0], v[1]), pk2(v[2], v[3]), pk2(v[4], v[5]), pk2(v[6], v[7])};
            *(u32x4*)dstp = w;
        }
        LDS_BARRIER();
#pragma unroll
        for (int i = 0; i < 8; ++i) vcur[i] = vnext[i];
        dstp = dstn;
    }
    bf16_t* sc = (bf16_t*)(lws(p) + WS_SC);
    for (int idx = lbid() * 512 + tid; idx < 256 * 1024; idx += gridDim.x * 512) {
        const int row = idx >> 10, col = idx & 1023; float v = 0.f;
        if (row < 8) v = silu_f(p.in[2][row * 1024 + col]); else if (row < NMB) v = silu_f(p.in[3][(row - 8) * 1024 + col]);
        sc[idx] = f2bf(v);
    }
    unsigned* hp = (unsigned*)(lws(p) + WS_H + (size_t)MTOT * 2048);
    for (int idx = lbid() * 512 + tid; idx < 65536; idx += gridDim.x * 512) hp[idx] = 0u;
}

__device__ __forceinline__ void phase_norm(const Params& p, LAS unsigned char* lds, int l, int which, const float* xp, const float* xs, float* xcopy) {
    const int tid = ltid(), wid = tid >> 6, lane = tid & 63;
    const float* gv = p.in[which == 0 ? 10 : (which == 1 ? 13 : 23)] + l * 1024;
    const float* mod = (const float*)(lws(p) + WS_MOD);
    bf16_t* H = (bf16_t*)(lws(p) + WS_H);
    float* pab = (float*)(lws(p) + WS_PAB);
    LAS float* wab = (LAS float*)lds;
    __syncthreads();
    if (which == 1) {
        const float* win = p.in[14] + (size_t)l * 1024 * 2824 + 2048;
        for (int i = tid; i < 2048; i += 512) { const int k = i >> 1, hf = i & 1; f32x4 v = *(const f32x4*)(win + (size_t)k * 2824 + 4 * hf); *(LAS f32x4*)(wab + k * 8 + 4 * hf) = v; }
    }
    __syncthreads();
    f32x4 g4[4];
#pragma unroll
    for (int i = 0; i < 4; ++i) g4[i] = *(const f32x4*)(gv + 256 * i + 4 * lane);
    auto do_row = [&](int r, const f32x4 (&x)[4], const f32x4 (&gs)[4], const f32x4 (&sh)[4]) {
        float ss = 0.f;
        if (xcopy != nullptr && r >= MPR) {
#pragma unroll
            for (int i = 0; i < 4; ++i) *(f32x4*)(xcopy + (size_t)r * 1024 + 256 * i + 4 * lane) = x[i];
        }
#pragma unroll
        for (int i = 0; i < 4; ++i) ss += x[i][0] * x[i][0] + x[i][1] * x[i][1] + x[i][2] * x[i][2] + x[i][3] * x[i][3];
        ss = wave_sum(ss);
        const float rstd = rsqrtf(ss * (1.0f / 1024.0f) + 1e-6f);
        float a0 = 0.f, a1 = 0.f, a2 = 0.f, a3 = 0.f, a4 = 0.f, a5 = 0.f, a6 = 0.f, a7 = 0.f;
#pragma unroll
        for (int i = 0; i < 4; ++i) {
            f32x4 h;
#pragma unroll
            for (int e = 0; e < 4; ++e) h[e] = x[i][e] * rstd * gs[i][e] + sh[i][e];
            u32x2 w = {pk2(h[0], h[1]), pk2(h[2], h[3])};
            *(u32x2*)(H + (size_t)r * 1024 + 256 * i + 4 * lane) = w;
            if (which == 1) {
#pragma unroll
                for (int e = 0; e < 4; ++e) {
                    const int k = 256 * i + 4 * lane + e;
                    const f32x4 w0 = *(const LAS f32x4*)(wab + k * 8), w1 = *(const LAS f32x4*)(wab + k * 8 + 4);
                    a0 += h[e] * w0[0]; a1 += h[e] * w0[1]; a2 += h[e] * w0[2]; a3 += h[e] * w0[3];
                    a4 += h[e] * w1[0]; a5 += h[e] * w1[1]; a6 += h[e] * w1[2]; a7 += h[e] * w1[3];
                }
            }
        }
        if (which == 1) {
            a0 = wave_sum(a0); a1 = wave_sum(a1); a2 = wave_sum(a2); a3 = wave_sum(a3); a4 = wave_sum(a4); a5 = wave_sum(a5); a6 = wave_sum(a6); a7 = wave_sum(a7);
            if (lane == 0) { f32x4 o0 = {a0, a1, a2, a3}, o1 = {a4, a5, a6, a7}; *(f32x4*)(pab + (size_t)r * 8) = o0; *(f32x4*)(pab + (size_t)r * 8 + 4) = o1; }
        }
    };
    auto load_mod = [&](int mb, f32x4 (&gs)[4], f32x4 (&sh)[4]) {
        const float* mrow = mod + (size_t)mb * MODW + l * 9216 + (3 * which) * 1024;
#pragma unroll
        for (int i = 0; i < 4; ++i) { sh[i] = *(const f32x4*)(mrow + 256 * i + 4 * lane); const f32x4 scl = *(const f32x4*)(mrow + 1024 + 256 * i + 4 * lane); gs[i] = g4[i] * (1.0f + scl); }
    };
    const int nwv = gridDim.x * 8, wg = lbid() * 8 + wid;
    for (int ck = wg; ck < MPR / 16; ck += nwv) {
        const int r0 = ck * 16;
        f32x4 gs[4], sh[4]; load_mod(r0 >> 12, gs, sh);
        const float* xb = xp + (size_t)r0 * 1024 + 4 * lane;
        f32x4 xa[4], xbuf[4], xc[4];
#pragma unroll
        for (int i = 0; i < 4; ++i) { xa[i] = *(const f32x4*)(xb + 256 * i); xbuf[i] = *(const f32x4*)(xb + 1024 + 256 * i); }
#pragma unroll 1
        for (int k = 0; k < 16; k += 2) {
            if (k + 2 < 16) {
#pragma unroll
                for (int i = 0; i < 4; ++i) xc[i] = *(const f32x4*)(xb + (size_t)(k + 2) * 1024 + 256 * i);
            }
            do_row(r0 + k, xa, gs, sh);
            if (k + 3 < 16) {
#pragma unroll
                for (int i = 0; i < 4; ++i) xa[i] = *(const f32x4*)(xb + (size_t)(k + 3) * 1024 + 256 * i);
            }
            do_row(r0 + k + 1, xbuf, gs, sh);
#pragma unroll
            for (int i = 0; i < 4; ++i) { xbuf[i] = xa[i]; xa[i] = xc[i]; }
        }
    }
    for (int sr = wg; sr < MTOT - MPR; sr += nwv) {
        const int r = MPR + sr;
        f32x4 gs[4], sh[4], x[4]; load_mod(8 + sr, gs, sh);
#pragma unroll
        for (int i = 0; i < 4; ++i) x[i] = *(const f32x4*)(xs + (size_t)sr * 1024 + 256 * i + 4 * lane);
        do_row(r, x, gs, sh);
    }
}

struct EpiAny {
    static constexpr bool PERM = true, AFTER_DRAIN = false;
    int kind; bf16_t* O; const float* xp; const float* xs; float* X; const float* gate; float s;
    __device__ __forceinline__ void operator()(const f32x4 (&acc)[2][2][4][2], const pg8::Unit& u, int wr, int wc, int fr, int fq) const {
        const int row0 = u.pm * 256 + wr * 64 + fr;
        if (kind == 0) {
            const int col0 = u.pn * 128 + wc * 32 + 8 * fq;
#pragma unroll
            for (int ai = 0; ai < 2; ++ai)
#pragma unroll
                for (int m = 0; m < 4; ++m) {
                    bf16_t* rowp = O + (size_t)(row0 + ai * 128 + m * 16) * 2816 + col0;
                    f32x4 v0, v1;
#pragma unroll
                    for (int e = 0; e < 4; ++e) { v0[e] = silu_f(acc[ai][0][m][0][e]) * acc[ai][1][m][0][e]; v1[e] = silu_f(acc[ai][0][m][1][e]) * acc[ai][1][m][1][e]; }
                    u32x4 w = {pk2(v0[0], v0[1]), pk2(v0[2], v0[3]), pk2(v1[0], v1[1]), pk2(v1[2], v1[3])};
                    *(u32x4*)rowp = w;
                }
        } else if (kind == 2) {
            const int col0 = u.pn * 256 + wc * 32 + 8 * fq;
#pragma unroll
            for (int ai = 0; ai < 2; ++ai)
#pragma unroll
                for (int m = 0; m < 4; ++m)
#pragma unroll
                    for (int bj = 0; bj < 2; ++bj) {
                        const f32x4 v0 = acc[ai][bj][m][0], v1 = acc[ai][bj][m][1];
                        u32x4 w = {pk2(v0[0], v0[1]), pk2(v0[2], v0[3]), pk2(v1[0], v1[1]), pk2(v1[2], v1[3])};
                        *(u32x4*)(O + (size_t)(row0 + ai * 128 + m * 16) * PW + col0 + bj * 128) = w;
                    }
        } else if (kind == 1) {
            const int col0 = u.pn * 256 + wc * 32 + 8 * fq;
            const float* gr = gate + (size_t)((u.pm * 256) >> 12) * MODW + col0;
            f32x4 gv[2][2];
#pragma unroll
            for (int bj = 0; bj < 2; ++bj)
#pragma unroll
                for (int n = 0; n < 2; ++n) gv[bj][n] = *(const f32x4*)(gr + bj * 128 + n * 4) * s;
#pragma unroll
            for (int ai = 0; ai < 2; ++ai)
#pragma unroll
                for (int mp = 0; mp < 2; ++mp) {
                    f32x4 xv[2][2][2];
#pragma unroll
                    for (int mm = 0; mm < 2; ++mm) {
                        const float* xr = xp + (size_t)(row0 + ai * 128 + (2 * mp + mm) * 16) * 1024 + col0;
#pragma unroll
                        for (int bj = 0; bj < 2; ++bj)
#pragma unroll
                            for (int n = 0; n < 2; ++n) xv[mm][bj][n] = *(const f32x4*)(xr + bj * 128 + n * 4);
                    }
#pragma unroll
                    for (int mm = 0; mm < 2; ++mm) {
                        float* o = X + (size_t)(row0 + ai * 128 + (2 * mp + mm) * 16) * 1024 + col0;
#pragma unroll
                        for (int bj = 0; bj < 2; ++bj)
#pragma unroll
                            for (int n = 0; n < 2; ++n) *(f32x4*)(o + bj * 128 + n * 4) = xv[mm][bj][n] + gv[bj][n] * acc[ai][bj][2 * mp + mm][n];
                    }
                }
        } else {
            const int col0 = u.pn * 256 + wc * 32 + 8 * fq;
            f32x4 gv[2][2];
#pragma unroll
            for (int bj = 0; bj < 2; ++bj)
#pragma unroll
                for (int n = 0; n < 2; ++n) gv[bj][n] = *(const f32x4*)(gate + col0 + bj * 128 + n * 4);
#pragma unroll
            for (int ai = 0; ai < 2; ++ai)
#pragma unroll
                for (int m = 0; m < 4; ++m) {
                    const int row = row0 + ai * 128 + m * 16;
                    if (row < NMB) {
                        float* o = X + (size_t)row * MODW + col0;
#pragma unroll
                        for (int bj = 0; bj < 2; ++bj)
#pragma unroll
                            for (int n = 0; n < 2; ++n) *(f32x4*)(o + bj * 128 + n * 4) = acc[ai][bj][m][n] + gv[bj][n];
                    }
                }
        }
    }
};
template <class Epi> __device__ __forceinline__ void run_gemm(LAS unsigned char* lds, const bf16_t* A, const bf16_t* Bt, int Mg, int N, int K, const Epi& E) {
    pg8::Gemm g{A, Bt, Mg, N, K}; pg8::StaticOrder S; S.init(Mg, N, (int)gridDim.x, lbid());
    __syncthreads();
    pg8::gemm_phase<Epi, pg8::StaticOrder, false>(lds, g, S, E, nullptr);
    __syncthreads();
}

template <int NSLAB, bool TWO> __device__ __forceinline__ void skinny_kloop(const bf16_t* arow, const bf16_t* b0, const bf16_t* b1, f32x4& acc0, f32x4& acc1) {
#pragma unroll
    for (int sl = 0; sl < NSLAB; ++sl) {
        const bf16x8 af = *(const bf16x8*)(arow + 32 * sl), bf0 = *(const bf16x8*)(b0 + 32 * sl);
        acc0 = MFMA16(bf0, af, acc0);
        if (TWO) { const bf16x8 bf1 = *(const bf16x8*)(b1 + 32 * sl); acc1 = MFMA16(bf1, af, acc1); }
    }
}
__device__ __forceinline__ void skinny_gemm(const EpiAny& E, const bf16_t* A, const bf16_t* Bt, int N, int K) {
    const int tid = ltid(), wid = tid >> 6, lane = tid & 63, fr = lane & 15, fq = lane >> 4;
    const int G = gridDim.x, nunits = E.kind == 1 ? (N / 16) * 4 : (E.kind == 0 ? N / 2 : N) / 16;
    const bf16_t* arow = A + (size_t)(MPR + 16 * wid + fr) * K + 8 * fq;
    for (int u = G - 1 - lbid(); u < nunits; u += G) {
        const int j0 = E.kind == 1 ? 16 * (u >> 2) : 16 * u;
        const int kbeg = E.kind == 1 ? (u & 3) * (K >> 2) : 0, kend = E.kind == 1 ? kbeg + (K >> 2) : K;
        const bf16_t* b0; const bf16_t* b1;
        if (E.kind == 0) { const int T = j0 >> 7, off = j0 & 127; b0 = Bt + (size_t)(256 * T + off + fr) * K + 8 * fq; b1 = b0 + (size_t)128 * K; }
        else { b0 = Bt + (size_t)(j0 + fr) * K + 8 * fq; b1 = b0; }
        f32x4 acc0 = {0.f, 0.f, 0.f, 0.f}, acc1 = {0.f, 0.f, 0.f, 0.f};
        if (E.kind == 0) skinny_kloop<32, true>(arow, b0, b1, acc0, acc1);
        else if (E.kind == 2) skinny_kloop<32, false>(arow, b0, b1, acc0, acc1);
        else if (K == 2816) skinny_kloop<22, false>(arow + kbeg, b0 + kbeg, b1, acc0, acc1);
        else skinny_kloop<8, false>(arow + kbeg, b0 + kbeg, b1, acc0, acc1);
        const int row = MPR + 16 * wid + fr, c = j0 + 4 * fq;
        if (E.kind == 0) {
            f32x4 v;
#pragma unroll
            for (int e = 0; e < 4; ++e) v[e] = silu_f(acc0[e]) * acc1[e];
            u32x2 w = {pk2(v[0], v[1]), pk2(v[2], v[3])};
            *(u32x2*)(E.O + (size_t)row * 2816 + c) = w;
        } else if (E.kind == 2) {
            u32x2 w = {pk2(acc0[0], acc0[1]), pk2(acc0[2], acc0[3])};
            *(u32x2*)(E.O + (size_t)row * PW + c) = w;
        } else {
            const float* gr = E.gate + (size_t)(8 + row - MPR) * MODW;
            const f32x4 gv = *(const f32x4*)(gr + c); float* o = E.X + (size_t)row * 1024 + c;
#pragma unroll
            for (int e = 0; e < 4; ++e) unsafeAtomicAdd(o + e, E.s * gv[e] * acc0[e]);
        }
    }
}

__device__ __forceinline__ void sample_dn(const Params& p, LAS unsigned char* lds, int l, int item) {
    const int tid = ltid(), wid = tid >> 6, lane = tid & 63;
    const int b = item >> 2, h = item & 3; const size_t r = (size_t)MPR + b;
    const bf16_t* P = (const bf16_t*)(lws(p) + WS_HID); bf16_t* MIX = (bf16_t*)(lws(p) + WS_H);
    const float* pab = (const float*)(lws(p) + WS_PAB);
    LAS float* yq = (LAS float*)lds; LAS float* yk = yq + 128; LAS float* yv = yk + 128; LAS float* red = yv + 128; LAS float* pk_ = red + 16; LAS float* pq_ = pk_ + 512;
    LDS_BARRIER();
    if (tid < 384) {
        const int sel = tid >> 7, d = tid & 127, cc = sel * 512 + h * 128 + d;
        const float x = bf2f(P[r * PW + cc]);
        const float* sb = p.in[4] + ((size_t)(l * 128 + b) * 3) * 1536 + cc;
        const float b0 = sb[0], b1 = sb[1536], b2 = sb[3072];
        const float* cw = p.in[15] + (size_t)l * 4 * 1536 + cc;
        const float y = cw[0] * b0 + cw[1536] * b1 + cw[3072] * b2 + cw[4608] * x;
        float* co = lout(p) + O_CVS + ((size_t)(l * 128 + b) * 3) * 1536 + cc;
        co[0] = b1; co[1536] = b2; co[3072] = x;
        yq[sel * 128 + d] = silu_f(y);
    }
    LDS_BARRIER();
    if (wid < 2) { const float a = yq[wid * 128 + lane], c2 = yq[wid * 128 + 64 + lane]; const float s = wave_sum(a * a + c2 * c2); if (lane == 0) red[wid] = s; }
    LDS_BARRIER();
    const float rq = rsqrtf(red[0] + 1e-6f) * 0.08838834764831845f, rk = rsqrtf(red[1] + 1e-6f);
    const float pb = pab[r * 8 + h], pa = pab[r * 8 + 4 + h];
    const float beta = 1.0f / (1.0f + expf(-pb));
    const float xx = pa + p.in[17][l * 4 + h];
    const float g = -expf(p.in[16][l * 4 + h]) * (fmaxf(xx, 0.f) + log1pf(expf(-fabsf(xx))));
    const float eg = expf(g);
    const int e = tid & 127, dq = tid >> 7;
    const float* S0 = p.in[5] + ((size_t)(l * 128 + b) * 4 + h) * 16384;
    float s[32]; float ak = 0.f, aq = 0.f;
#pragma unroll
    for (int i = 0; i < 32; ++i) { const int d = 32 * dq + i; s[i] = S0[d * 128 + e]; ak += yk[d] * rk * s[i]; aq += yq[d] * rq * s[i]; }
    pk_[dq * 128 + e] = ak; pq_[dq * 128 + e] = aq;
    const float qk = wave_sum(yq[lane] * yk[lane] + yq[64 + lane] * yk[64 + lane]) * rq * rk;
    LDS_BARRIER();
    const float kS = pk_[e] + pk_[128 + e] + pk_[256 + e] + pk_[384 + e], qS = pq_[e] + pq_[128 + e] + pq_[256 + e] + pq_[384 + e];
    const float vnew = beta * (yv[e] - eg * kS), o = eg * qS + qk * vnew;
    float* So = lout(p) + O_SS + ((size_t)(l * 128 + b) * 4 + h) * 16384;
#pragma unroll
    for (int i = 0; i < 32; ++i) { const int d = 32 * dq + i; So[d * 128 + e] = eg * s[i] + yk[d] * rk * vnew; }
    if (tid < 128) { const float ss = wave_sum(o * o); if (lane == 0) red[4 + wid] = ss; }
    LDS_BARRIER();
    if (tid < 128) {
        const float rstd = rsqrtf((red[4] + red[5]) * (1.0f / 128.0f) + 1e-6f);
        const float z = bf2f(P[r * PW + ZC + h * 128 + e]);
        MIX[r * 1024 + h * 128 + e] = f2bf(o * rstd * p.in[18][l * 128 + e] * silu_f(z));
    }
}

__device__ __forceinline__ void sample_swa(const Params& p, LAS unsigned char* lds, int l, int b) {
    const int tid = ltid(), wid = tid >> 6, lane = tid & 63;
    const size_t r = (size_t)MPR + b;
    const bf16_t* P = (const bf16_t*)(lws(p) + WS_HID); bf16_t* MIX = (bf16_t*)(lws(p) + WS_H);
    LAS float* qs = (LAS float*)lds; LAS float* ks = qs + 512; LAS float* vs = ks + 128; LAS float* ps = vs + 128;
    LDS_BARRIER();
    if (tid < 320) {
        const int head = tid >> 5, i = tid & 31;
        const float inv = exp2f(-(float)i * (13.287712379549449f / 32.0f));
        float rev = (16384.0f * inv) * 0.15915494309189535f; rev -= floorf(rev);
        const float sn = __builtin_amdgcn_sinf(rev), cs = __builtin_amdgcn_cosf(rev);
        const int col = (head < 8 ? SQ + head * 64 : SK + (head - 8) * 64) + i;
        const float x1 = bf2f(P[r * PW + col]), x2 = bf2f(P[r * PW + col + 32]);
        float ss = x1 * x1 + x2 * x2;
        ss = row16_sum(ss); ss += __shfl_xor(ss, 16);
        const float rstd = rsqrtf(ss * (1.0f / 64.0f) + 1e-6f);
        const float* nw = p.in[head < 8 ? 19 : 20] + l * 64;
        const float y1 = x1 * rstd * nw[i], y2 = x2 * rstd * nw[i + 32];
        const float o1 = y1 * cs - y2 * sn, o2 = y2 * cs + y1 * sn;
        if (head < 8) { qs[head * 64 + i] = o1 * 0.125f; qs[head * 64 + i + 32] = o2 * 0.125f; }
        else { ks[(head - 8) * 64 + i] = o1; ks[(head - 8) * 64 + i + 32] = o2; }
    }
    if (tid >= 384) { const int c = tid - 384; vs[c] = bf2f(P[r * PW + SV + c]); }
    LDS_BARRIER();
    const float* ck = p.in[6] + (size_t)(l * 128 + b) * 16384; const float* cv = p.in[7] + (size_t)(l * 128 + b) * 16384;
    float* ko = lout(p) + O_KS + (size_t)(l * 128 + b) * 16384; float* vo = lout(p) + O_VS + (size_t)(l * 128 + b) * 16384;
    for (int idx = tid; idx < 4096; idx += 512) {
        const int j = idx >> 5, c4 = idx & 31; f32x4 kv, vv;
        if (j < 127) { kv = *(const f32x4*)(ck + (j + 1) * 128 + 4 * c4); vv = *(const f32x4*)(cv + (j + 1) * 128 + 4 * c4); }
        else { kv = *(const LAS f32x4*)(ks + 4 * c4); vv = *(const LAS f32x4*)(vs + 4 * c4); }
        *(f32x4*)(ko + j * 128 + 4 * c4) = kv; *(f32x4*)(vo + j * 128 + 4 * c4) = vv;
    }
    {
        const int h = wid, hk = h >> 2; float s0 = 0.f, s1 = 0.f, s2 = 0.f;
        const float* k0 = ck + lane * 128 + hk * 64; const float* k1 = ck + (lane + 64) * 128 + hk * 64;
#pragma unroll
        for (int c4 = 0; c4 < 16; ++c4) {
            const f32x4 q4 = *(const LAS f32x4*)(qs + h * 64 + 4 * c4), a = *(const f32x4*)(k0 + 4 * c4), bb = *(const f32x4*)(k1 + 4 * c4), kk = *(const LAS f32x4*)(ks + hk * 64 + 4 * c4);
            s0 += q4[0] * a[0] + q4[1] * a[1] + q4[2] * a[2] + q4[3] * a[3];
            s1 += q4[0] * bb[0] + q4[1] * bb[1] + q4[2] * bb[2] + q4[3] * bb[3];
            s2 += q4[0] * kk[0] + q4[1] * kk[1] + q4[2] * kk[2] + q4[3] * kk[3];
        }
        const float sink = p.in[21][l * 8 + h];
        const float m = fmaxf(fmaxf(wave_max(fmaxf(s0, s1)), s2), sink);
        const float p0 = __expf(s0 - m), p1 = __expf(s1 - m), p2 = __expf(s2 - m);
        const float sum = wave_sum(p0 + p1) + p2 + __expf(sink - m);
        ps[h * 132 + lane] = p0; ps[h * 132 + 64 + lane] = p1;
        if (lane == 0) { ps[h * 132 + 128] = p2; ps[h * 132 + 129] = 1.0f / sum; }
    }
    LDS_BARRIER();
    {
        const int h = wid, hk = h >> 2, d = lane; float o = 0.f;
        for (int j = 0; j < 128; ++j) o += ps[h * 132 + j] * cv[j * 128 + hk * 64 + d];
        o += ps[h * 132 + 128] * vs[hk * 64 + d]; o *= ps[h * 132 + 129];
        MIX[r * 1024 + 512 + h * 64 + d] = f2bf(o);
    }
}

__device__ __forceinline__ void swa_prep(const Params& p, int l) {
    const int tid = ltid(), wid = tid >> 6, lane = tid & 63, i = lane & 31;
    bf16_t* P = (bf16_t*)(lws(p) + WS_HID);
    const float inv = exp2f(-(float)i * (13.287712379549449f / 32.0f));
    const float qw1 = p.in[19][l * 64 + i], qw2 = p.in[19][l * 64 + i + 32], kw1 = p.in[20][l * 64 + i], kw2 = p.in[20][l * 64 + i + 32];
    for (int r0 = (lbid() * 8 + wid) * 2; r0 < MPR; r0 += gridDim.x * 16) {
        float x1[2][5], x2[2][5]; unsigned vv[2][2];
#pragma unroll
        for (int rr = 0; rr < 2; ++rr) {
            const bf16_t* pr = P + (size_t)(r0 + rr) * PW;
#pragma unroll
            for (int k = 0; k < 5; ++k) {
                const int head = 2 * k + (lane >> 5);
                const int col = (head < 8 ? SQ + head * 64 : SK + (head - 8) * 64) + i;
                x1[rr][k] = bf2f(pr[col]); x2[rr][k] = bf2f(pr[col + 32]);
            }
            vv[rr][0] = pr[SV + lane]; vv[rr][1] = pr[SV + 64 + lane];
        }
#pragma unroll
        for (int rr = 0; rr < 2; ++rr) {
            const int r = r0 + rr, t = r & 4095, b = r >> 12;
            float rev = ((float)t * inv) * 0.15915494309189535f; rev -= floorf(rev);
            const float sn = __builtin_amdgcn_sinf(rev), cs = __builtin_amdgcn_cosf(rev);
            bf16_t* pr = P + (size_t)r * PW;
#pragma unroll
            for (int k = 0; k < 5; ++k) {
                const int head = 2 * k + (lane >> 5);
                const int col = (head < 8 ? SQ + head * 64 : SK + (head - 8) * 64) + i;
                float ss = x1[rr][k] * x1[rr][k] + x2[rr][k] * x2[rr][k];
                ss = row16_sum(ss); ss += __shfl_xor(ss, 16);
                const float rstd = rsqrtf(ss * (1.0f / 64.0f) + 1e-6f);
                const float y1 = x1[rr][k] * rstd * (head < 8 ? qw1 : kw1), y2 = x2[rr][k] * rstd * (head < 8 ? qw2 : kw2);
                float o1 = y1 * cs - y2 * sn, o2 = y2 * cs + y1 * sn;
                if (head < 8) { o1 *= 0.125f; o2 *= 0.125f; }
                pr[col] = f2bf(o1); pr[col + 32] = f2bf(o2);
                if (head >= 8 && t >= 3968) { float* ko = lout(p) + O_KP + (((size_t)l * 8 + b) * 128 + (t - 3968)) * 128 + (head - 8) * 64 + i; ko[0] = o1; ko[32] = o2; }
            }
            if (t >= 3968) { float* vo = lout(p) + O_VP + (((size_t)l * 8 + b) * 128 + (t - 3968)) * 128; vo[lane] = bf2f((unsigned short)vv[rr][0]); vo[lane + 64] = bf2f((unsigned short)vv[rr][1]); }
        }
    }
}

__device__ __forceinline__ void dn_chunk_prep(const Params& p, LAS unsigned char* lds, int l, int chid, int next_chid) {
    const int tid = ltid(), wid = tid >> 6, lane = tid & 63, fr = lane & 15, fq = lane >> 4;
    const int h = chid & 3, n = (chid >> 2) & 63, b = chid >> 8;
    const bf16_t* P = (const bf16_t*)(lws(p) + WS_HID);
    const float* pab = (const float*)(lws(p) + WS_PAB);
    bf16_t* UT = (bf16_t*)(lws(p) + WS_UT); bf16_t* Wg = (bf16_t*)(lws(p) + WS_W); bf16_t* QD = (bf16_t*)(lws(p) + WS_QD); bf16_t* KDT = (bf16_t*)(lws(p) + WS_KDT);
    bf16_t* QKM = (bf16_t*)(lws(p) + WS_QKM); float* GLE = (float*)(lws(p) + WS_GLE);
    LAS unsigned char* qn = lds; LAS unsigned char* kn = lds + 17408;
    LAS float* VB = (LAS float*)(lds + 34816); LAS float* KBG = (LAS float*)(lds + 67584); LAS float* AM = (LAS float*)(lds + 100352);
    LAS float* GC = (LAS float*)(lds + 116736); LAS float* BETA = GC + 64;
    const size_t rbase = (size_t)b * 4096 + n * 64;
    LDS_BARRIER();
    float beta_t, gc_t;
    {
        const float* pr = pab + (rbase + lane) * 8; const float pb = pr[h], pa = pr[4 + h];
        beta_t = 1.0f / (1.0f + expf(-pb));
        const float xx = pa + p.in[17][l * 4 + h];
        float v = -expf(p.in[16][l * 4 + h]) * (fmaxf(xx, 0.f) + log1pf(expf(-fabsf(xx))));
#pragma unroll
        for (int o = 1; o < 64; o <<= 1) { const float t = __shfl_up(v, o); if (lane >= o) v += t; }
        gc_t = v;
        if (wid == 0) { GC[lane] = gc_t; BETA[lane] = beta_t; }
    }
    {
        const float* cw = p.in[15] + (size_t)l * 4 * 1536 + h * 128 + 2 * lane;
        float wq[4][2], wk[4][2], wv[4][2];
#pragma unroll
        for (int j = 0; j < 4; ++j)
#pragma unroll
            for (int e = 0; e < 2; ++e) { wq[j][e] = cw[j * 1536 + e]; wk[j][e] = cw[j * 1536 + 512 + e]; wv[j][e] = cw[j * 1536 + 1024 + e]; }
        float xq[11][2], xk[11][2], xv[11][2];
#pragma unroll
        for (int j = 0; j < 11; ++j) {
            const int ts = n * 64 + 8 * wid + j - 3;
            const bf16_t* pr = P + ((size_t)b * 4096 + (ts >= 0 ? ts : 0)) * PW + h * 128 + 2 * lane;
            unsigned uq = *(const unsigned*)pr, uk = *(const unsigned*)(pr + 512), uv = *(const unsigned*)(pr + 1024);
            if (ts < 0) { uq = 0u; uk = 0u; uv = 0u; }
            xq[j][0] = lo_bf(uq); xq[j][1] = hi_bf(uq); xk[j][0] = lo_bf(uk); xk[j][1] = hi_bf(uk); xv[j][0] = lo_bf(uv); xv[j][1] = hi_bf(uv);
        }
#pragma unroll
        for (int i = 0; i < 8; ++i) {
            const int c = 8 * wid + i;
            float yq[2], yk[2], yv[2];
#pragma unroll
            for (int e = 0; e < 2; ++e) {
                yq[e] = silu_f(wq[0][e] * xq[i][e] + wq[1][e] * xq[i + 1][e] + wq[2][e] * xq[i + 2][e] + wq[3][e] * xq[i + 3][e]);
                yk[e] = silu_f(wk[0][e] * xk[i][e] + wk[1][e] * xk[i + 1][e] + wk[2][e] * xk[i + 2][e] + wk[3][e] * xk[i + 3][e]);
                yv[e] = silu_f(wv[0][e] * xv[i][e] + wv[1][e] * xv[i + 1][e] + wv[2][e] * xv[i + 2][e] + wv[3][e] * xv[i + 3][e]);
            }
            const float sq = wave_sum(yq[0] * yq[0] + yq[1] * yq[1]), sk = wave_sum(yk[0] * yk[0] + yk[1] * yk[1]);
            const float rq = rsqrtf(sq + 1e-6f) * 0.08838834764831845f, rk = rsqrtf(sk + 1e-6f);
            const float gcc = __shfl(gc_t, c), bc = __shfl(beta_t, c); const float eg = __expf(gcc);
            const float q0 = yq[0] * rq, q1 = yq[1] * rq, k0 = yk[0] * rk, k1 = yk[1] * rk;
            *(LAS unsigned*)(qn + c * 272 + 4 * lane) = pk2(q0, q1);
            *(LAS unsigned*)(kn + c * 272 + 4 * lane) = pk2(k0, k1);
            f32x2 vb = {yv[0] * bc, yv[1] * bc}, kb = {k0 * bc * eg, k1 * bc * eg};
            *(LAS f32x2*)(VB + c * 128 + 2 * lane) = vb; *(LAS f32x2*)(KBG + c * 128 + 2 * lane) = kb;
            *(unsigned*)(QD + ((size_t)chid * 64 + c) * 128 + kpos(2 * lane)) = pk2(q0 * eg, q1 * eg);
        }
    }
    LDS_BARRIER();
#pragma unroll
    for (int it = 0; it < 4; ++it) {
        const int id = wid * 4 + it, isqk = id >> 4, ti = (id >> 2) & 3, tj = id & 3;
        f32x4 acc = {0.f, 0.f, 0.f, 0.f};
        if (ti >= tj) {
            const LAS unsigned char* bsrc = isqk ? qn : kn;
#pragma unroll
            for (int s = 0; s < 4; ++s) {
                const bf16x8 a = *(const LAS bf16x8*)(kn + (16 * tj + fr) * 272 + (32 * s + 8 * fq) * 2);
                const bf16x8 bb = *(const LAS bf16x8*)(bsrc + (16 * ti + fr) * 272 + (32 * s + 8 * fq) * 2);
                acc = MFMA16(a, bb, acc);
            }
        }
        const int i = 16 * ti + fr; const float gi = GC[i], bi = BETA[i];
        f32x4 val;
#pragma unroll
        for (int jj = 0; jj < 4; ++jj) {
            const int j = 16 * tj + 4 * fq + jj;
            const float v = acc[jj] * __expf(fminf(gi - GC[j], 0.f));
            val[jj] = isqk ? ((i >= j) ? v : 0.f) : ((i > j) ? v * bi : 0.f);
        }
        if (isqk) { u32x2 w = {pk2(val[0], val[1]), pk2(val[2], val[3])}; *(u32x2*)(QKM + ((size_t)chid * 64 + i) * 64 + kpos(16 * tj + 4 * fq)) = w; }
        else *(LAS f32x4*)(AM + i * 64 + 16 * tj + 4 * fq) = val;
    }
    LDS_BARRIER();
    if (wid < 4) {
        const LAS float* mat = (wid < 2) ? VB : KBG; const int d = (wid & 1) * 64 + lane;
        f32x2 x2[32];
#pragma unroll
        for (int c = 0; c < 32; ++c) x2[c] = (f32x2){mat[(2 * c) * 128 + d], mat[(2 * c + 1) * 128 + d]};
        const LAS float* am = AM; asm volatile("" : "+v"(am));
        f32x4 abuf[2][16];
        abuf[1][0] = *(const LAS f32x4*)(am + 64);
#pragma unroll
        for (int i = 1; i < 64; ++i) {
            if (i + 1 < 64) {
#pragma unroll
                for (int j4 = 0; j4 < (i + 4) / 4; ++j4) abuf[(i + 1) & 1][j4] = *(const LAS f32x4*)(am + (i + 1) * 64 + 4 * j4);
            }
            SCHED_FENCE();
            f32x2 sA = {0.f, 0.f}, sB = {0.f, 0.f};
#pragma unroll
            for (int j4 = 0; j4 < (i + 3) / 4; ++j4) {
                const f32x4 a = abuf[i & 1][j4];
                sA = __builtin_elementwise_fma(__builtin_shufflevector(a, a, 0, 1), x2[2 * j4], sA);
                sB = __builtin_elementwise_fma(__builtin_shufflevector(a, a, 2, 3), x2[2 * j4 + 1], sB);
            }
            const f32x2 st = sA + sB;
            x2[i >> 1][i & 1] -= st[0] + st[1];
            SCHED_FENCE();
        }
        float x[64];
#pragma unroll
        for (int c = 0; c < 32; ++c) { x[2 * c] = x2[c][0]; x[2 * c + 1] = x2[c][1]; }
        if (wid < 2) {
            bf16_t* ut = UT + ((size_t)chid * 128 + d) * 64;
#pragma unroll
            for (int k = 0; k < 8; ++k) { u32x4 w = {pk2(x[8 * k], x[8 * k + 1]), pk2(x[8 * k + 2], x[8 * k + 3]), pk2(x[8 * k + 4], x[8 * k + 5]), pk2(x[8 * k + 6], x[8 * k + 7])}; *(u32x4*)(ut + 8 * k) = w; }
        } else {
            bf16_t* wp = Wg + (size_t)chid * 8192 + kpos(d);
#pragma unroll
            for (int c = 0; c < 64; ++c) wp[c * 128] = f2bf(x[c]);
        }
    } else {
        const int t2 = tid - 256, d = t2 & 127, hf = t2 >> 7; const float gl = GC[63];
        unsigned pfd = 0u;
        if (next_chid >= 0) {
            const int h2 = next_chid & 3, n2 = (next_chid >> 2) & 63, b2 = next_chid >> 8;
#pragma unroll
            for (int k2 = 0; k2 < 2; ++k2) {
                const int idx = t2 + 256 * k2;
                if (idx < 402) {
                    const int rr = idx / 6, pc = idx % 6; const int ts = n2 * 64 + rr - 3;
                    const char* ap = (const char*)(P + ((size_t)b2 * 4096 + (ts >= 0 ? ts : 0)) * PW + (pc >> 1) * 512 + h2 * 128) + (pc & 1) * 128;
                    asm volatile("global_load_dword %0, %1, off" : "+v"(pfd) : "v"(ap) : "memory");
                }
            }
            if (t2 < 16) { const char* ap = (const char*)(pab + ((size_t)b2 * 4096 + n2 * 64) * 8) + t2 * 128; asm volatile("global_load_dword %0, %1, off" : "+v"(pfd) : "v"(ap) : "memory"); }
        }
#pragma unroll
        for (int c8 = 0; c8 < 4; ++c8) {
            float v[8];
#pragma unroll
            for (int e = 0; e < 8; ++e) { const int c = 32 * hf + 8 * c8 + e; v[e] = bf2f(*(const LAS bf16_t*)(kn + c * 272 + 2 * d)) * __expf(gl - GC[c]); }
            u32x2 w0 = {pk2(v[0], v[1]), pk2(v[2], v[3])}, w1 = {pk2(v[4], v[5]), pk2(v[6], v[7])};
            bf16_t* kdrow = KDT + ((size_t)chid * 128 + d) * 64;
            *(u32x2*)(kdrow + kpos(32 * hf + 8 * c8)) = w0; *(u32x2*)(kdrow + kpos(32 * hf + 8 * c8 + 4)) = w1;
        }
        if (t2 == 0) GLE[chid] = expf(gl);
        asm volatile("s_waitcnt vmcnt(0)" ::: "memory");
        asm volatile("" :: "v"(pfd));
    }
}

constexpr int SCAN_CW = 4, SCAN_BPC = 2, SCAN_NBLK = 64;
constexpr int SC_OFF_W = 0, SC_OFF_QD = 17408, SC_OFF_KDT = 34816, SC_OFF_QK = 53248, SC_OFF_U = 62464, SC_BUFSZ = 71680;
__device__ __forceinline__ bf16x8 rd16(const LAS unsigned char* p) { return *(const LAS bf16x8*)p; }
__device__ __forceinline__ void dn_scan_step(const LAS unsigned char* base, f32x4 (&S)[8], const LAS unsigned char* urow, float gle, bf16_t* orow, int fr, int fq) {
    bf16x8 sf[4];
#pragma unroll
    for (int s = 0; s < 4; ++s) sf[s] = pack_frag(S[2 * s], S[2 * s + 1]);
    bf16x8 wq[2][8], kf[4][2];
    u32x2 uc[4];
#pragma unroll
    for (int t = 0; t < 4; ++t) uc[t] = *(const LAS u32x2*)(urow + 32 * t);
    f32x4 vn[4], oT[4];
#pragma unroll
    for (int s = 0; s < 4; ++s) { wq[0][s] = rd16(base + SC_OFF_W + fr * 272 + 64 * s + 16 * fq); wq[0][4 + s] = rd16(base + SC_OFF_QD + fr * 272 + 64 * s + 16 * fq); }
#pragma unroll
    for (int t = 0; t < 4; ++t) {
        if (t < 3) {
#pragma unroll
            for (int s = 0; s < 4; ++s) { wq[(t + 1) & 1][s] = rd16(base + SC_OFF_W + (16 * (t + 1) + fr) * 272 + 64 * s + 16 * fq); wq[(t + 1) & 1][4 + s] = rd16(base + SC_OFF_QD + (16 * (t + 1) + fr) * 272 + 64 * s + 16 * fq); }
        } else {
#pragma unroll
            for (int tt = 0; tt < 4; ++tt)
#pragma unroll
                for (int s = 0; s < 2; ++s) kf[tt][s] = rd16(base + SC_OFF_QK + (16 * tt + fr) * 144 + 64 * s + 16 * fq);
        }
        SCHED_FENCE();
        f32x4 a1 = {0.f, 0.f, 0.f, 0.f}, a2 = {0.f, 0.f, 0.f, 0.f};
#pragma unroll
        for (int s = 0; s < 4; ++s) { a1 = MFMA16(wq[t & 1][s], sf[s], a1); a2 = MFMA16(sf[s], wq[t & 1][4 + s], a2); }
        vn[t] = (f32x4){lo_bf(uc[t][0]) - a1[0], hi_bf(uc[t][0]) - a1[1], lo_bf(uc[t][1]) - a1[2], hi_bf(uc[t][1]) - a1[3]}; oT[t] = a2;
        SCHED_FENCE();
    }
    bf16x8 vf[2]; vf[0] = pack_frag(vn[0], vn[1]); vf[1] = pack_frag(vn[2], vn[3]);
    bf16x8 kda[4][2], kdb[4][2];
#pragma unroll
    for (int t = 0; t < 4; ++t)
#pragma unroll
        for (int s = 0; s < 2; ++s) kda[t][s] = rd16(base + SC_OFF_KDT + (16 * t + fr) * 144 + 64 * s + 16 * fq);
    SCHED_FENCE();
#pragma unroll
    for (int t = 0; t < 4; ++t) {
#pragma unroll
        for (int s = 0; s < 2; ++s) oT[t] = MFMA16(vf[s], kf[t][s], oT[t]);
    }
#pragma unroll
    for (int t = 0; t < 4; ++t)
#pragma unroll
        for (int s = 0; s < 2; ++s) kdb[t][s] = rd16(base + SC_OFF_KDT + (16 * (t + 4) + fr) * 144 + 64 * s + 16 * fq);
    SCHED_FENCE();
#pragma unroll
    for (int t = 0; t < 4; ++t) {
        f32x4 a = S[t] * gle;
#pragma unroll
        for (int s = 0; s < 2; ++s) a = MFMA16(kda[t][s], vf[s], a);
        S[t] = a;
    }
#pragma unroll
    for (int t = 0; t < 4; ++t) { u32x2 w_ = {pk2(oT[t][0], oT[t][1]), pk2(oT[t][2], oT[t][3])}; *(u32x2*)(orow + (size_t)(16 * t) * 1024) = w_; }
    SCHED_FENCE();
#pragma unroll
    for (int t = 0; t < 4; ++t) {
        f32x4 a = S[4 + t] * gle;
#pragma unroll
        for (int s = 0; s < 2; ++s) a = MFMA16(kdb[t][s], vf[s], a);
        S[4 + t] = a;
    }
}
__device__ __forceinline__ void dn_scan(const Params& p, LAS unsigned char* lds, int l, int item) {
    const int tid = ltid(), wid = tid >> 6, lane = tid & 63, fr = lane & 15, fq = lane >> 4;
    const int chain = (item >> 4) * 8 + (item & 7), part = (item >> 3) & 1;
    const int b = chain >> 2, h = chain & 3, n0 = 16 * (part * 4 + (wid & 3));
    const bool cw = wid < 4;
    const bf16_t* UT = (const bf16_t*)(lws(p) + WS_UT); const bf16_t* Wg = (const bf16_t*)(lws(p) + WS_W); const bf16_t* QD = (const bf16_t*)(lws(p) + WS_QD);
    const bf16_t* KDT = (const bf16_t*)(lws(p) + WS_KDT); const bf16_t* QKM = (const bf16_t*)(lws(p) + WS_QKM); const float* GLE = (const float*)(lws(p) + WS_GLE);
    bf16_t* MIX = (bf16_t*)(lws(p) + WS_H);
    const int lt = tid - 256;
    const float gle_all = GLE[(b * 64 + lane) * 4 + h];
#define DN_LOAD(st, nn) do { const size_t ch_ = (size_t)((b * 64 + (nn)) * 4 + h); \
        const u32x4* g0_ = (const u32x4*)(Wg + ch_ * 8192); const u32x4* g1_ = (const u32x4*)(QD + ch_ * 8192); const u32x4* g2_ = (const u32x4*)(KDT + ch_ * 8192); const u32x4* g3_ = (const u32x4*)(QKM + ch_ * 4096); \
        const u32x4* g4_ = (const u32x4*)(UT + (ch_ * 128 + part * 64) * 64); \
        _Pragma("unroll") for (int k_ = 0; k_ < 6; ++k_) { const int c_ = lt + 192 * k_; if (k_ < 5 || lt < 64) { st[k_] = g0_[c_]; st[6 + k_] = g1_[c_]; st[12 + k_] = g2_[c_]; } } \
        _Pragma("unroll") for (int k_ = 0; k_ < 3; ++k_) { const int c_ = lt + 192 * k_; if (k_ < 2 || lt < 128) { st[18 + k_] = g3_[c_]; st[21 + k_] = g4_[c_]; } } } while (0)
#define DN_WRITE(st, buf) do { LAS unsigned char* bb_ = lds + (buf) * SC_BUFSZ; \
        _Pragma("unroll") for (int k_ = 0; k_ < 6; ++k_) { const int c_ = lt + 192 * k_; if (k_ < 5 || lt < 64) { \
            *(LAS u32x4*)(bb_ + SC_OFF_W + (c_ >> 4) * 272 + (c_ & 15) * 16) = st[k_]; *(LAS u32x4*)(bb_ + SC_OFF_QD + (c_ >> 4) * 272 + (c_ & 15) * 16) = st[6 + k_]; \
            *(LAS u32x4*)(bb_ + SC_OFF_KDT + (c_ >> 3) * 144 + (c_ & 7) * 16) = st[12 + k_]; } } \
        _Pragma("unroll") for (int k_ = 0; k_ < 3; ++k_) { const int c_ = lt + 192 * k_; if (k_ < 2 || lt < 128) { \
            *(LAS u32x4*)(bb_ + SC_OFF_QK + (c_ >> 3) * 144 + (c_ & 7) * 16) = st[18 + k_]; *(LAS u32x4*)(bb_ + SC_OFF_U + (c_ >> 3) * 144 + (c_ & 7) * 16) = st[21 + k_]; } } } while (0)
#define DN_TOUCH(nn) do { const size_t ch_ = (size_t)((b * 64 + (nn)) * 4 + h); \
        _Pragma("unroll") for (int k_ = 0; k_ < 2; ++k_) { \
            asm volatile("global_load_dword %0, %1, off" : "+v"(pfd) : "v"((const char*)(Wg + ch_ * 8192) + (lane + 64 * k_) * 128) : "memory"); \
            asm volatile("global_load_dword %0, %1, off" : "+v"(pfd) : "v"((const char*)(QD + ch_ * 8192) + (lane + 64 * k_) * 128) : "memory"); \
            asm volatile("global_load_dword %0, %1, off" : "+v"(pfd) : "v"((const char*)(KDT + ch_ * 8192) + (lane + 64 * k_) * 128) : "memory"); } \
        asm volatile("global_load_dword %0, %1, off" : "+v"(pfd) : "v"((const char*)(QKM + ch_ * 4096) + lane * 128) : "memory"); \
        asm volatile("global_load_dword %0, %1, off" : "+v"(pfd) : "v"((const char*)(UT + (ch_ * 128 + part * 64) * 64) + lane * 128) : "memory"); } while (0)
    __syncthreads();
    if (cw) {
        f32x4 S[8];
#pragma unroll
        for (int t = 0; t < 8; ++t) S[t] = (f32x4){0.f, 0.f, 0.f, 0.f};
        const int uoff = SC_OFF_U + (16 * wid + fr) * 144 + 8 * fq;
        LDS_BARRIER();
        for (int n = 0; n < 64; n += 2) {
            dn_scan_step(lds, S, lds + uoff, __shfl(gle_all, n), MIX + ((size_t)b * 4096 + n * 64 + fr) * 1024 + h * 128 + n0 + 4 * fq, fr, fq);
            LDS_BARRIER();
            dn_scan_step(lds + SC_BUFSZ, S, lds + SC_BUFSZ + uoff, __shfl(gle_all, n + 1), MIX + ((size_t)b * 4096 + (n + 1) * 64 + fr) * 1024 + h * 128 + n0 + 4 * fq, fr, fq);
            LDS_BARRIER();
        }
        float* So = lout(p) + O_SP + ((size_t)(l * 8 + b) * 4 + h) * 16384;
#pragma unroll
        for (int t = 0; t < 8; ++t)
#pragma unroll
            for (int jj = 0; jj < 4; ++jj) So[(16 * t + 4 * fq + jj) * 128 + n0 + fr] = S[t][jj];
    } else if (wid < 7) {
        u32x4 sa[24], sb[24];
        DN_LOAD(sa, 0); DN_WRITE(sa, 0); DN_LOAD(sa, 1);
        LDS_BARRIER();
        for (int n = 0; n < 64; n += 2) {
            if (n + 2 < 64) DN_LOAD(sb, n + 2);
            DN_WRITE(sa, 1);
            LDS_BARRIER();
            if (n + 3 < 64) DN_LOAD(sa, n + 3);
            if (n + 2 < 64) DN_WRITE(sb, 0);
            LDS_BARRIER();
        }
    } else {
        constexpr int SCAN_PF = 5;
        unsigned pfd = 0u;
#pragma unroll
        for (int m = 2; m < 2 + SCAN_PF; ++m) DN_TOUCH(m);
        LDS_BARRIER();
        for (int n = 0; n < 64; ++n) {
            if (n + 2 + SCAN_PF < 64) DN_TOUCH(n + 2 + SCAN_PF);
            asm volatile("s_waitcnt vmcnt(32)" ::: "memory");
            LDS_BARRIER();
        }
        asm volatile("s_waitcnt vmcnt(0)" ::: "memory");
        asm volatile("" :: "v"(pfd));
    }
#undef DN_LOAD
#undef DN_WRITE
#undef DN_TOUCH
}

__device__ __forceinline__ void swa_attn_unit(const Params& p, LAS unsigned char* lds, int l, int unit) {
    const int tid = ltid(), wid = tid >> 6, lane = tid & 63, fr = lane & 15, fq = lane >> 4;
    const int hk = unit & 1, nb = (unit >> 1) & 31, b = unit >> 6;
    const bf16_t* P = (const bf16_t*)(lws(p) + WS_HID); bf16_t* MIX = (bf16_t*)(lws(p) + WS_H);
    LAS unsigned char* Ks = lds; LAS unsigned char* Vt = lds + 36864;
    LDS_BARRIER();
#pragma unroll
    for (int it = 0; it < 4; ++it) {
        const int c = tid + 512 * it;
        { const int kj = c >> 3, c8 = c & 7; int tl = (nb - 1) * 128 + kj; if (tl < 0) tl += 128;
          const u32x4 kv = *(const u32x4*)(P + ((size_t)b * 4096 + tl) * PW + SK + hk * 64 + c8 * 8);
          *(LAS u32x4*)(Ks + kj * 144 + c8 * 16) = kv; }
        { const int kj = c & 255, c8 = c >> 8; int tl = (nb - 1) * 128 + kj; if (tl < 0) tl += 128;
          const u32x4 vv = *(const u32x4*)(P + ((size_t)b * 4096 + tl) * PW + SV + hk * 64 + c8 * 8);
#pragma unroll
          for (int e = 0; e < 8; ++e) *(LAS bf16_t*)(Vt + (c8 * 8 + e) * 528 + kj * 2) = (bf16_t)((e & 1) ? (vv[e >> 1] >> 16) : (vv[e >> 1] & 0xffffu)); }
    }
    LDS_BARRIER();
    for (int it = 0; it < 4; ++it) {
        const int combo = wid * 4 + it, hq = combo >> 3, qt = combo & 7, head = hk * 4 + hq;
        const size_t tq = (size_t)b * 4096 + nb * 128 + 16 * qt + fr;
        bf16x8 qf[2];
#pragma unroll
        for (int ks = 0; ks < 2; ++ks) qf[ks] = *(const bf16x8*)(P + tq * PW + SQ + head * 64 + 32 * ks + 8 * fq);
        f32x4 sc[10];
#pragma unroll
        for (int u = 0; u < 9; ++u) {
            f32x4 a = {0.f, 0.f, 0.f, 0.f};
#pragma unroll
            for (int ks = 0; ks < 2; ++ks) { const bf16x8 kf = *(const LAS bf16x8*)(Ks + (16 * (qt + u) + fr) * 144 + (32 * ks + 8 * fq) * 2); a = MFMA16(kf, qf[ks], a); }
            sc[u] = a;
        }
        sc[9] = (f32x4){0.f, 0.f, 0.f, 0.f};
        const float sink = p.in[21][l * 8 + head];
        float m = sink;
#pragma unroll
        for (int u = 0; u < 9; ++u)
#pragma unroll
            for (int jj = 0; jj < 4; ++jj) {
                const int kk = 16 * u + 4 * fq + jj;
                const bool valid = (kk >= fr) && (kk <= fr + 128) && (nb > 0 || 16 * qt + kk >= 128);
                sc[u][jj] = valid ? sc[u][jj] : -__builtin_inff();
                m = fmaxf(m, sc[u][jj]);
            }
        m = fmaxf(m, __shfl_xor(m, 16)); m = fmaxf(m, __shfl_xor(m, 32));
        float sum = 0.f;
#pragma unroll
        for (int u = 0; u < 9; ++u)
#pragma unroll
            for (int jj = 0; jj < 4; ++jj) { const float pv = __expf(sc[u][jj] - m); sc[u][jj] = pv; sum += pv; }
        sum += __shfl_xor(sum, 16); sum += __shfl_xor(sum, 32);
        sum += __expf(sink - m);
        const float rinv = 1.0f / sum;
        f32x4 o[4];
#pragma unroll
        for (int dt = 0; dt < 4; ++dt) o[dt] = (f32x4){0.f, 0.f, 0.f, 0.f};
#pragma unroll
        for (int s = 0; s < 5; ++s) {
            const bf16x8 pf = pack_frag(sc[2 * s], sc[2 * s + 1]);
            const int kb = 16 * (qt + 2 * s), kb2 = (s < 4) ? kb + 16 : kb;
#pragma unroll
            for (int dt = 0; dt < 4; ++dt) {
                const u32x2 lo = *(const LAS u32x2*)(Vt + (16 * dt + fr) * 528 + (kb + 4 * fq) * 2), hi = *(const LAS u32x2*)(Vt + (16 * dt + fr) * 528 + (kb2 + 4 * fq) * 2);
                o[dt] = MFMA16(mk8(lo[0], lo[1], hi[0], hi[1]), pf, o[dt]);
            }
        }
#pragma unroll
        for (int dt = 0; dt < 4; ++dt) {
            u32x2 w = {pk2(o[dt][0] * rinv, o[dt][1] * rinv), pk2(o[dt][2] * rinv, o[dt][3] * rinv)};
            *(u32x2*)(MIX + tq * 1024 + 512 + head * 64 + 16 * dt + 4 * fq) = w;
        }
    }
}

__device__ __forceinline__ void phase_gnorm(const Params& p, int l) {
    const int tid = ltid(), wid = tid >> 6, lane = tid & 63;
    const bf16_t* P = (const bf16_t*)(lws(p) + WS_HID); bf16_t* MIX = (bf16_t*)(lws(p) + WS_H);
    const float* nw = p.in[18] + l * 128 + ((8 * lane) & 127);
    const f32x4 n0 = *(const f32x4*)nw, n1 = *(const f32x4*)(nw + 4);
    const int nwv = gridDim.x * 8;
    for (int ck = lbid() * 8 + wid; ck < MPR / 16; ck += nwv) {
        const int r0 = ck * 16;
        u32x4 ovn = *(const u32x4*)(MIX + (size_t)r0 * 1024 + 8 * lane), zvn = *(const u32x4*)(P + (size_t)r0 * PW + ZC + 8 * lane);
#pragma unroll 1
        for (int k = 0; k < 16; ++k) {
            const int r = r0 + k;
            bf16_t* mp = MIX + (size_t)r * 1024 + 8 * lane;
            const u32x4 ov = ovn, zv = zvn;
            if (k + 1 < 16) { ovn = *(const u32x4*)(mp + 1024); zvn = *(const u32x4*)(P + (size_t)(r + 1) * PW + ZC + 8 * lane); }
            float o[8], z[8];
#pragma unroll
            for (int e = 0; e < 4; ++e) { o[2 * e] = lo_bf(ov[e]); o[2 * e + 1] = hi_bf(ov[e]); z[2 * e] = lo_bf(zv[e]); z[2 * e + 1] = hi_bf(zv[e]); }
            float ss = 0.f;
#pragma unroll
            for (int e = 0; e < 8; ++e) ss += o[e] * o[e];
            ss = row16_sum(ss);
            const float rstd = rsqrtf(ss * (1.0f / 128.0f) + 1e-6f);
            float y[8];
#pragma unroll
            for (int e = 0; e < 8; ++e) y[e] = o[e] * rstd * (e < 4 ? n0[e] : n1[e - 4]) * silu_f(z[e]);
            u32x4 w = {pk2(y[0], y[1]), pk2(y[2], y[3]), pk2(y[4], y[5]), pk2(y[6], y[7])};
            *(u32x4*)mp = w;
        }
    }
}

__global__ void __launch_bounds__(512, 2) hymba_megakernel(Params p) {
    extern __shared__ __attribute__((aligned(16))) unsigned char shm[];
    LAS unsigned char* lds = (LAS unsigned char*)shm;
    volatile LAS unsigned* xbst = (volatile LAS unsigned*)(lds + LDS_XB);
    if (threadIdx.x < 4) xbst[threadIdx.x] = 0u;
    __syncthreads();
    (void)xcd_barrier_post((unsigned*)(p.ws + WS_BAR), xbst);
    for (int ph = p.ph_lo; ph < p.ph_hi; ++ph) {
        const int tid = ltid();
        unsigned char* wsb = lws(p);
        bf16_t* wt = (bf16_t*)(wsb + WS_WT);
        bf16_t* H = (bf16_t*)(wsb + WS_H); bf16_t* HID = (bf16_t*)(wsb + WS_HID);
        float* MOD = (float*)(wsb + WS_MOD);
        float* X = lout(p);
        const int l = ph < 2 ? 0 : (ph - 2) / 12, sub = ph < 2 ? -1 : (ph - 2) % 12;
        const bool first = (l == 0 && sub < 3);
        const float* xp = first ? p.in[0] : X; const float* xs = first ? p.in[1] : X + (size_t)MPR * 1024;
        const bf16_t* wl = wt + l * LW_EL;
        const bool is_gemm = (ph == 1) || sub == 1 || sub == 2 || sub == 4 || sub == 8 || sub == 10 || sub == 11;
        if (is_gemm) {
            {
                EpiAny E{}; const bf16_t* A = H; const bf16_t* Bt; int Mg = MPR, N, K = 1024;
                E.xp = xp; E.xs = xs; E.X = X; E.O = HID; E.s = 0.5f; E.gate = MOD;
                if (ph == 1) { E.kind = 3; A = (const bf16_t*)(lws(p) + WS_SC); Bt = (const bf16_t*)(lws(p) + WS_ADA); Mg = 256; N = MODW; E.X = MOD; E.gate = p.in[9]; }
                else if (sub == 1) { E.kind = 0; Bt = wl + W_GU1; N = 5632; }
                else if (sub == 10) { E.kind = 0; Bt = wl + W_GU2; N = 5632; }
                else if (sub == 2) { E.kind = 1; A = HID; Bt = wl + W_DN1; N = 1024; K = 2816; E.gate = MOD + l * 9216 + 2 * 1024; }
                else if (sub == 11) { E.kind = 1; A = HID; Bt = wl + W_DN2; N = 1024; K = 2816; E.gate = MOD + l * 9216 + 8 * 1024; }
                else if (sub == 8) { E.kind = 1; Bt = wl + W_OUT; N = 1024; E.s = 1.0f; E.gate = MOD + l * 9216 + 5 * 1024; }
                else { E.kind = 2; Bt = wl + W_IN; N = 2816; }
                run_gemm(lds, A, Bt, Mg, N, K, E);
                if (ph != 1) skinny_gemm(E, A, Bt, N, K);
            }
        }
        else if (ph == 0) { phase_prep(p, lds); }
        else if (sub == 0 || sub == 3 || sub == 9) { phase_norm(p, lds, l, sub == 0 ? 0 : (sub == 3 ? 1 : 2), xp, xs, (l == 0 && sub == 0) ? X : nullptr); }
        else if (sub == 5) {
            swa_prep(p, l);
            for (int ch = lbid(); ch < 2048; ch += gridDim.x) { const int nx = ch + (int)gridDim.x; dn_chunk_prep(p, lds, l, ch, nx < 2048 ? nx : -1); }
            for (int idx = lbid() * 512 + tid; idx < 8 * 3 * 1536; idx += gridDim.x * 512) {
                const int cc = idx % 1536, j = (idx / 1536) % 3, b = idx / 4608;
                lout(p)[O_CVP + (size_t)l * 36864 + idx] = bf2f(HID[((size_t)b * 4096 + 4093 + j) * PW + cc]);
            }
        }
        else if (sub == 6) {
            const int G = gridDim.x;
            if (G > SCAN_NBLK) { if (lbid() < SCAN_NBLK) { dn_scan(p, lds, l, lbid()); } else {
                for (int u = lbid() - SCAN_NBLK; u < 512; u += G - SCAN_NBLK) { swa_attn_unit(p, lds, l, u); }
                for (int it = G - 1 - lbid(); it < 640; it += G - SCAN_NBLK) { if (it < 512) sample_dn(p, lds, l, it); else sample_swa(p, lds, l, it - 512); }
            } }
            else { for (int c = lbid(); c < SCAN_NBLK; c += G) dn_scan(p, lds, l, c); for (int u = lbid(); u < 512; u += G) swa_attn_unit(p, lds, l, u); for (int it = lbid(); it < 640; it += G) { if (it < 512) sample_dn(p, lds, l, it); else sample_swa(p, lds, l, it - 512); } }
        }
        else if (sub == 7) phase_gnorm(p, l);
        if (ph + 1 < p.ph_hi && p.coop) { if (ph == 0) cg::this_grid().sync(); else { XcdBarrier xb; xb.bar = (unsigned*)(lws(p) + WS_BAR); xb.x = xb_xcc_id(); xb.st = (volatile LAS unsigned*)(lds + LDS_XB); xcd_barrier(xb); } }
    }
}

#ifndef MK_MULTI
#define MK_MULTI 0
#endif
extern "C" void kernel_launch(void* const* d_in, const int* in_sizes, int n_in, void* d_out, int out_size, void* d_ws, size_t ws_size, hipStream_t stream) {
    static int grid = 0;
    if (grid == 0) {
        if (n_in != 26 || ws_size < WS_TOTAL) { fprintf(stderr, "kernel_launch: n_in %d ws %zu (need %zu)\n", n_in, ws_size, (size_t)WS_TOTAL); grid = -1; return; }
        int dev = 0, cus = 0, per_cu = 0;
        hipGetDevice(&dev);
        hipDeviceGetAttribute(&cus, hipDeviceAttributeMultiprocessorCount, dev);
        if (hipFuncSetAttribute((const void*)hymba_megakernel, hipFuncAttributeMaxDynamicSharedMemorySize, LDS_BYTES) != hipSuccess) { fprintf(stderr, "kernel_launch: hipFuncSetAttribute failed\n"); grid = -1; return; }
        if (hipOccupancyMaxActiveBlocksPerMultiprocessor(&per_cu, (const void*)hymba_megakernel, 512, LDS_BYTES) != hipSuccess || per_cu < 1) { fprintf(stderr, "kernel_launch: occupancy query says %d\n", per_cu); per_cu = 1; }
        (void)hipGetLastError();
        grid = cus * 1;
        if (grid < 1) grid = 256;
    }
    if (grid < 0) return;
    (void)hipMemsetAsync((unsigned char*)d_ws + WS_BAR, 0, 16384, stream);
    Params p{};
    for (int i = 0; i < 26; ++i) p.in[i] = (const float*)d_in[i];
    p.out = (float*)d_out; p.ws = (unsigned char*)d_ws;
#if MK_MULTI
    for (int ph = 0; ph < NPHASE; ++ph) { p.ph_lo = ph; p.ph_hi = ph + 1; p.coop = 0; hipLaunchKernelGGL(hymba_megakernel, dim3(grid), dim3(512), LDS_BYTES, stream, p); }
#else
    p.ph_lo = 0; p.ph_hi = NPHASE; p.coop = 1;
    void* args[] = {&p};
    hipError_t e = hipLaunchCooperativeKernel((const void*)hymba_megakernel, dim3(grid), dim3(512), args, LDS_BYTES, stream);
    if (e != hipSuccess) fprintf(stderr, "cooperative launch failed: %s (grid %d)\n", hipGetErrorString(e), grid);
#endif
}
```
